# Optimizing an MI355X kernel written in HIP

```python
import jax, jax.numpy as jnp
from jax import lax
import numpy as np

D_MODEL = 4096
BATCH = 4
SEQ = 2048
DEPTH = 2
DEC_BATCH = 32
DEC_SEQ = 4
PAST_LEN = 16384
PAGE_SIZE = 128

D_A = D_MODEL // 2
SHORT_CONV_W = 3
D_B = D_MODEL // 2
POOL_WINDOWS = (2, 4, 8, 16)
N_POOL_GROUPS = len(POOL_WINDOWS)
POOL_GROUP = D_B // N_POOL_GROUPS
POOL_CTX = max(POOL_WINDOWS) - 1
HEAD_DIM = 64
N_HEADS = D_MODEL // HEAD_DIM
N_KV_HEADS = 8
GQA_GROUP = N_HEADS // N_KV_HEADS
QKV_WIDTH = (N_HEADS + 2 * N_KV_HEADS) * HEAD_DIM
WINDOW = 128
ATTN_BLOCK = 128
ROPE_THETA = 10000.0
D_FF = 11008
FFN_CONV_W = 3
N_EVEN = (DEPTH + 1) // 2
N_ODD = DEPTH // 2
EPS = 1e-6

kernel_name = 'hybrid_shortconv_pool_swa_convffn_step'


def rms_norm(x, g):
    xf = x.astype(jnp.float32)
    y = xf * lax.rsqrt(jnp.mean(xf * xf, axis=-1, keepdims=True) + EPS)
    return (y * g.astype(jnp.float32)).astype(x.dtype)


def causal_dwconv(ctx, x, w):
    width = w.shape[0]
    T = x.shape[1]
    z = jnp.concatenate([ctx.astype(x.dtype), x], axis=1)
    y = z[:, 0:T] * w[0]
    for k in range(1, width):
        y = y + z[:, k:k + T] * w[k]
    return y, z[:, z.shape[1] - (width - 1):]


def rope(x, pos):
    half = HEAD_DIM // 2
    inv = ROPE_THETA ** (-jnp.arange(half, dtype=jnp.float32) / half)
    ang = pos.astype(jnp.float32)[:, None] * inv[None, :]
    cos = jnp.cos(ang)[None, :, None, :]
    sin = jnp.sin(ang)[None, :, None, :]
    xf = x.astype(jnp.float32)
    x1, x2 = xf[..., :half], xf[..., half:]
    return jnp.concatenate([x1 * cos - x2 * sin, x2 * cos + x1 * sin], axis=-1).astype(x.dtype)


def pool_mixer(p_in, ctx, pos, w_grp, scale):
    T = p_in.shape[1]
    z = jnp.concatenate([ctx.astype(p_in.dtype), p_in], axis=1)
    zf = z.astype(jnp.float32)
    cs = jnp.concatenate([jnp.zeros_like(zf[:, :1]), lax.cumsum(zf, axis=1)], axis=1)
    xf = p_in.astype(jnp.float32)
    groups = []
    for g, w in enumerate(POOL_WINDOWS):
        sl = slice(g * POOL_GROUP, (g + 1) * POOL_GROUP)
        hi = cs[:, POOL_CTX + 1:POOL_CTX + 1 + T, sl]
        lo = cs[:, POOL_CTX + 1 - w:POOL_CTX + 1 - w + T, sl]
        cnt = jnp.minimum(pos + 1, w).astype(jnp.float32)[None, :, None]
        groups.append((hi - lo) / cnt - xf[..., sl])
    pooled = jnp.stack(groups, axis=2)
    y = jnp.einsum('btgc,gcd->btgd', pooled, w_grp.astype(jnp.float32)).reshape(p_in.shape)
    y = y * scale.astype(jnp.float32)
    return y.astype(p_in.dtype), z[:, z.shape[1] - POOL_CTX:]


def sink_attention(q, k, v, q_pos, k_pos, sinks):
    B, N, Tq = q.shape[:3]
    qg = q.reshape(B, N, Tq, N_KV_HEADS, GQA_GROUP, HEAD_DIM).astype(jnp.float32)
    s = jnp.einsum('bnqkgd,bnskd->bnkgqs', qg, k.astype(jnp.float32)) * (HEAD_DIM ** -0.5)
    kp = k_pos[:, None, :]
    qp = q_pos[:, :, None]
    mask = (kp <= qp) & (kp > qp - WINDOW) & (kp >= 0)
    s = jnp.where(mask[None, :, None, None], s, -jnp.inf)
    sk = sinks.astype(jnp.float32).reshape(N_KV_HEADS, GQA_GROUP)[None, None, :, :, None, None]
    m = jnp.maximum(jnp.max(s, axis=-1, keepdims=True), sk)
    p = jnp.exp(s - m)
    p = p / (jnp.sum(p, axis=-1, keepdims=True) + jnp.exp(sk - m))
    o = jnp.einsum('bnkgqs,bnskd->bnqkgd', p, v.astype(jnp.float32))
    return o.reshape(B, N, Tq, N_HEADS * HEAD_DIM).astype(v.dtype)


def swa_mixer(h, pos, w_qkv, b_qkv, sinks, w_o, k_buf, v_buf, banded):
    B, T, _ = h.shape
    qkv = h @ w_qkv + b_qkv
    nq = N_HEADS * HEAD_DIM
    nk = N_KV_HEADS * HEAD_DIM
    q = rope(qkv[..., :nq].reshape(B, T, N_HEADS, HEAD_DIM), pos)
    k = rope(qkv[..., nq:nq + nk].reshape(B, T, N_KV_HEADS, HEAD_DIM), pos)
    v = qkv[..., nq + nk:].reshape(B, T, N_KV_HEADS, HEAD_DIM)
    if banded:
        nb = T // ATTN_BLOCK
        qb = q.reshape(B, nb, ATTN_BLOCK, N_HEADS, HEAD_DIM)
        kb = k.reshape(B, nb, ATTN_BLOCK, N_KV_HEADS, HEAD_DIM)
        vb = v.reshape(B, nb, ATTN_BLOCK, N_KV_HEADS, HEAD_DIM)
        kk = jnp.concatenate([jnp.concatenate([jnp.zeros_like(kb[:, :1]), kb[:, :-1]], axis=1), kb], axis=2)
        vv = jnp.concatenate([jnp.concatenate([jnp.zeros_like(vb[:, :1]), vb[:, :-1]], axis=1), vb], axis=2)
        blk_pos = pos.reshape(nb, ATTN_BLOCK)
        q_pos = blk_pos
        k_pos = blk_pos[:, :1] - ATTN_BLOCK + jnp.arange(2 * ATTN_BLOCK, dtype=jnp.int32)[None, :]
        o = sink_attention(qb, kk, vv, q_pos, k_pos, sinks).reshape(B, T, nq)
        new_k = k[:, T - WINDOW:]
        new_v = v[:, T - WINDOW:]
    else:
        kk = jnp.concatenate([k_buf.astype(k.dtype), k], axis=1)
        vv = jnp.concatenate([v_buf.astype(v.dtype), v], axis=1)
        q_pos = pos[None, :]
        k_pos = jnp.concatenate([pos[0] - WINDOW + jnp.arange(WINDOW, dtype=jnp.int32), pos])[None, :]
        o = sink_attention(q[:, None], kk[:, None], vv[:, None], q_pos, k_pos, sinks)[:, 0]
        new_k = kk[:, kk.shape[1] - WINDOW:]
        new_v = vv[:, vv.shape[1] - WINDOW:]
    return o @ w_o, new_k, new_v


def run_trunk(x, start, conv_ctx, pool_ctx, k_buf, v_buf, ffn_ctx,
              norm_mix, w_in_ab, conv_a, w_pool, pool_scale, w_out_ab,
              w_qkv, b_qkv, sinks, w_o, norm_ffn, w_up, conv_ffn, w_down, norm_final, banded):
    T = x.shape[1]
    pos = start + jnp.arange(T, dtype=jnp.int32)
    new_conv, new_pool, new_k, new_v, new_ffn = [], [], [], [], []
    for layer in range(DEPTH):
        i = layer // 2
        h = rms_norm(x, norm_mix[layer])
        if layer % 2 == 0:
            proj = h @ w_in_ab[i]
            gate_b = proj[..., :D_A]
            gate_c = proj[..., D_A:2 * D_A]
            x_a = proj[..., 2 * D_A:3 * D_A]
            p_b = proj[..., 3 * D_A:]
            conv_y, nc = causal_dwconv(conv_ctx[i], gate_c * x_a, conv_a[i])
            y_b, npl = pool_mixer(p_b, pool_ctx[i], pos, w_pool[i], pool_scale[i])
            x = x + jnp.concatenate([gate_b * conv_y, y_b], axis=-1) @ w_out_ab[i]
            new_conv.append(nc)
            new_pool.append(npl)
        else:
            kb = None if k_buf is None else k_buf[i]
            vb = None if v_buf is None else v_buf[i]
            att, nk, nv = swa_mixer(h, pos, w_qkv[i], b_qkv[i], sinks[i], w_o[i], kb, vb, banded)
            x = x + att
            new_k.append(nk)
            new_v.append(nv)
        h = rms_norm(x, norm_ffn[layer])
        u, nf = causal_dwconv(ffn_ctx[layer], h @ w_up[layer], conv_ffn[layer])
        x = x + (jax.nn.silu(u[..., :D_FF]) * u[..., D_FF:]) @ w_down[layer]
        new_ffn.append(nf)
    y = rms_norm(x, norm_final)
    return y, jnp.stack(new_conv), jnp.stack(new_pool), jnp.stack(new_k), jnp.stack(new_v), jnp.stack(new_ffn)


def setup_inputs(seed: int = 0) -> dict:
    key = jax.random.key(seed)
    ks = jax.random.split(key, 22)
    f32 = jnp.float32

    def nrm(k, shape, scale):
        return jax.random.normal(k, shape, f32) * scale

    return {
        'x_prompt': nrm(ks[0], (BATCH, SEQ, D_MODEL), 1.0),
        'x_sample': nrm(ks[1], (DEC_BATCH, DEC_SEQ, D_MODEL), 1.0),
        'state_conv_a': nrm(ks[2], (N_EVEN, DEC_BATCH, SHORT_CONV_W - 1, D_A), 1.0),
        'state_pool': nrm(ks[3], (N_EVEN, DEC_BATCH, POOL_CTX, D_B), 1.0),
        'cache_win_k': nrm(ks[4], (N_ODD, DEC_BATCH, WINDOW, N_KV_HEADS, HEAD_DIM), 1.0),
        'cache_win_v': nrm(ks[5], (N_ODD, DEC_BATCH, WINDOW, N_KV_HEADS, HEAD_DIM), 1.0),
        'state_ffn_conv': nrm(ks[6], (DEPTH, DEC_BATCH, FFN_CONV_W - 1, 2 * D_FF), 1.0),
        'norm_mix': 1.0 + nrm(ks[7], (DEPTH, D_MODEL), 0.02),
        'w_in_ab': nrm(ks[8], (N_EVEN, D_MODEL, 3 * D_A + D_B), D_MODEL ** -0.5),
        'conv_a': nrm(ks[9], (N_EVEN, SHORT_CONV_W, D_A), SHORT_CONV_W ** -0.5),
        'w_pool': nrm(ks[10], (N_EVEN, N_POOL_GROUPS, POOL_GROUP, POOL_GROUP), POOL_GROUP ** -0.5),
        'pool_scale': 1.0 + nrm(ks[11], (N_EVEN, D_B), 0.02),
        'w_out_ab': nrm(ks[12], (N_EVEN, D_A + D_B, D_MODEL), (D_A + D_B) ** -0.5),
        'w_qkv': nrm(ks[13], (N_ODD, D_MODEL, QKV_WIDTH), D_MODEL ** -0.5),
        'b_qkv': nrm(ks[14], (N_ODD, QKV_WIDTH), 0.02),
        'sinks': nrm(ks[15], (N_ODD, N_HEADS), 1.0),
        'w_o': nrm(ks[16], (N_ODD, N_HEADS * HEAD_DIM, D_MODEL), (N_HEADS * HEAD_DIM) ** -0.5),
        'norm_ffn': 1.0 + nrm(ks[17], (DEPTH, D_MODEL), 0.02),
        'w_up': nrm(ks[18], (DEPTH, D_MODEL, 2 * D_FF), D_MODEL ** -0.5),
        'conv_ffn': nrm(ks[19], (DEPTH, FFN_CONV_W, 2 * D_FF), FFN_CONV_W ** -0.5),
        'w_down': nrm(ks[20], (DEPTH, D_FF, D_MODEL), D_FF ** -0.5),
        'norm_final': 1.0 + nrm(ks[21], (D_MODEL,), 0.02),
    }


def reference(x_prompt, x_sample, state_conv_a, state_pool, cache_win_k, cache_win_v, state_ffn_conv,
              norm_mix, w_in_ab, conv_a, w_pool, pool_scale, w_out_ab,
              w_qkv, b_qkv, sinks, w_o, norm_ffn, w_up, conv_ffn, w_down, norm_final):
    dt = x_prompt.dtype
    bp = x_prompt.shape[0]
    zero_conv = jnp.zeros((N_EVEN, bp, SHORT_CONV_W - 1, D_A), dt)
    zero_pool = jnp.zeros((N_EVEN, bp, POOL_CTX, D_B), dt)
    zero_ffn = jnp.zeros((DEPTH, bp, FFN_CONV_W - 1, 2 * D_FF), dt)
    y_prompt, ca_p, pl_p, k_p, v_p, f_p = run_trunk(
        x_prompt, 0, zero_conv, zero_pool, None, None, zero_ffn,
        norm_mix, w_in_ab, conv_a, w_pool, pool_scale, w_out_ab,
        w_qkv, b_qkv, sinks, w_o, norm_ffn, w_up, conv_ffn, w_down, norm_final, True)
    y_sample, ca_s, pl_s, k_s, v_s, f_s = run_trunk(
        x_sample, PAST_LEN, state_conv_a, state_pool, cache_win_k, cache_win_v, state_ffn_conv,
        norm_mix, w_in_ab, conv_a, w_pool, pool_scale, w_out_ab,
        w_qkv, b_qkv, sinks, w_o, norm_ffn, w_up, conv_ffn, w_down, norm_final, False)
    return (y_prompt, y_sample, ca_p, ca_s, pl_p, pl_s, k_p, k_s, v_p, v_s, f_p, f_s)
```

```cpp
#include <hip/hip_runtime.h>
#include <cstdio>
#include <cstdint>

#ifndef PROBE_DUP_GEMM
#define PROBE_DUP_GEMM 0
#endif
#ifndef PROBE_DUP_MASK
#define PROBE_DUP_MASK 0
#endif
#define REP(k) for (int _r = 0; _r < 1 + ((PROBE_DUP_MASK >> (k)) & 1); ++_r)
#ifndef CONV_IN_P0
#define CONV_IN_P0 1
#endif
#ifndef BG_CONV
#define BG_CONV 1
#endif
#ifndef MK_SPLIT
#define MK_SPLIT 0
#endif

#define GAS __attribute__((address_space(1)))
#define LAS __attribute__((address_space(3)))
typedef unsigned short bf16_t;
typedef short bf16x8 __attribute__((ext_vector_type(8)));
typedef float f32x4 __attribute__((ext_vector_type(4)));
typedef float f32x2 __attribute__((ext_vector_type(2)));
typedef float f32x16 __attribute__((ext_vector_type(16)));
typedef unsigned u32x4 __attribute__((ext_vector_type(4)));
typedef unsigned u32x2 __attribute__((ext_vector_type(2)));
typedef __bf16 bf16x2_t __attribute__((ext_vector_type(2)));

constexpr int DM = 4096;
constexpr int MP = 8192, MS = 128, MR = MP + MS, MPAD = 8448, NPANEL = MPAD / 256;
constexpr int TP = 2048, NBP = 4, NBS = 32, TS = 4, PAST = 16384;
constexpr int DA = 2048, DB = 2048, NIN = 8192, PGRP = 512;
constexpr int DFF = 11008, NUP = 22016;
constexpr int NQKV = 5120, NH = 64, NKV = 8, HD = 64, WIN = 128;
constexpr float EPS = 1e-6f;

constexpr size_t O_Y = 0;
constexpr size_t O_CA_P = (size_t)MR * DM;
constexpr size_t O_CA_S = O_CA_P + 4 * 2 * 2048;
constexpr size_t O_PL_P = O_CA_S + 32 * 2 * 2048;
constexpr size_t O_PL_S = O_PL_P + 4 * 15 * 2048;
constexpr size_t O_K_P = O_PL_S + 32 * 15 * 2048;
constexpr size_t O_K_S = O_K_P + 4 * 128 * 512;
constexpr size_t O_V_P = O_K_S + 32 * 128 * 512;
constexpr size_t O_V_S = O_V_P + 4 * 128 * 512;
constexpr size_t O_F_P = O_V_S + 32 * 128 * 512;
constexpr size_t O_F_S = O_F_P + (size_t)2 * 4 * 2 * NUP;
constexpr size_t O_END = O_F_S + (size_t)2 * 32 * 2 * NUP;

constexpr size_t MiB = 1u << 20;
constexpr size_t al(size_t x) { return (x + MiB - 1) / MiB * MiB; }
constexpr size_t WS_CTL = 0, CTL_ZERO_BYTES = 1 * MiB;
constexpr size_t WS_ROPE = 1 * MiB;
constexpr size_t WS_WIN = 2 * MiB;
constexpr size_t WS_WPOOL = WS_WIN + al((size_t)NIN * DM * 2);
constexpr size_t WS_WOUT = WS_WPOOL + al((size_t)4 * 512 * 512 * 2);
constexpr size_t WS_WQKV = WS_WOUT + al((size_t)DM * DM * 2);
constexpr size_t WS_WO = WS_WQKV + al((size_t)NQKV * DM * 2);
constexpr size_t WS_WUP = WS_WO + al((size_t)DM * DM * 2);
constexpr size_t WUP_STRIDE = (size_t)NUP * DM;
constexpr size_t WS_WDN = WS_WUP + al(2 * WUP_STRIDE * 2);
constexpr size_t WDN_STRIDE = (size_t)DM * DFF;
constexpr size_t WS_X = WS_WDN + al(2 * WDN_STRIDE * 2);
constexpr size_t WS_H = WS_X + al((size_t)MPAD * DM * 4);
constexpr size_t WS_PROJ = WS_H + al((size_t)MPAD * DM * 2);
constexpr size_t WS_CAT = WS_PROJ + al((size_t)MPAD * NIN * 2);
constexpr size_t WS_POOLED = WS_CAT + al((size_t)MPAD * DM * 2);
constexpr size_t WS_U = WS_POOLED + al((size_t)MPAD * DB * 2);
constexpr size_t WS_ACT = WS_U + al((size_t)MPAD * NUP * 2);
constexpr size_t WS_SLAB = WS_ACT + al((size_t)MPAD * DFF * 2);
constexpr size_t WS_HALO = WS_SLAB + 32 * MiB;
constexpr size_t WS_END = WS_HALO + al((size_t)32 * 16 * NUP * 4);
constexpr size_t WS_ROWSS = WS_ROPE + 640 * 1024;
constexpr size_t WS_IGAIN = WS_ROPE + 900 * 1024;
constexpr int CW_FOLD = 8192;
constexpr int CW_BAR = 4096;

constexpr int RING_BYTES = 131072;
constexpr int LDS_BYTES = 147456;
constexpr int WLDS_OFF = 131072;
constexpr int LDSCTL_OFF = LDS_BYTES - 1024, MISC_OFF = LDSCTL_OFF + 320;
constexpr int NWAVES = 8, NTHR = 512;

__device__ __forceinline__ unsigned cvtpk(float lo, float hi) { f32x2 v = {lo, hi}; bf16x2_t b = __builtin_convertvector(v, bf16x2_t); return __builtin_bit_cast(unsigned, b); }
__device__ __forceinline__ float bflo(unsigned w) { return __uint_as_float(w << 16); }
__device__ __forceinline__ float bfhi(unsigned w) { return __uint_as_float(w & 0xffff0000u); }
__device__ __forceinline__ void load8(const bf16_t* p, float (&v)[8]) {
    const u32x4 w = *(const u32x4*)p;
    v[0] = bflo(w.x); v[1] = bfhi(w.x); v[2] = bflo(w.y); v[3] = bfhi(w.y); v[4] = bflo(w.z); v[5] = bfhi(w.z); v[6] = bflo(w.w); v[7] = bfhi(w.w);
}
__device__ __forceinline__ void store8(bf16_t* p, const float (&v)[8]) {
    u32x4 w; w.x = cvtpk(v[0], v[1]); w.y = cvtpk(v[2], v[3]); w.z = cvtpk(v[4], v[5]); w.w = cvtpk(v[6], v[7]);
    *(u32x4*)p = w;
}
__device__ __forceinline__ void loadf8(const float* p, float (&v)[8]) {
    const f32x4 a = *(const f32x4*)p, b = *(const f32x4*)(p + 4);
    v[0] = a.x; v[1] = a.y; v[2] = a.z; v[3] = a.w; v[4] = b.x; v[5] = b.y; v[6] = b.z; v[7] = b.w;
}
__device__ __forceinline__ void storef8(float* p, const float (&v)[8]) {
    *(f32x4*)p = (f32x4){v[0], v[1], v[2], v[3]}; *(f32x4*)(p + 4) = (f32x4){v[4], v[5], v[6], v[7]};
}
__device__ __forceinline__ float wave_sum(float v) {
#pragma unroll
    for (int o = 1; o < 64; o <<= 1) v += __shfl_xor(v, o);
    return v;
}

namespace pg8 {
constexpr int BM = 256, BK = 64, HALF = 128, HTB = HALF * BK * 2, STAGE_BYTES = 8 * HTB, NXCD = 8, WGM = 8;
__host__ __device__ __forceinline__ int lds_byte(int r, int c) { const int st = (r >> 4) * 2 + (c >> 5), rr = r & 15, cc = c & 31, ob = rr * 64 + cc * 2; return st * 1024 + (ob ^ (((ob >> 9) & 1) << 5)); }
__host__ __device__ __forceinline__ void stage_rc(int b, int& R, int& C) { const int st = b / 1024, sb = b % 1024, swz = sb ^ (((sb >> 9) & 1) << 5); R = (st >> 1) * 16 + swz / 64; C = (st & 1) * 32 + (swz % 64) / 2; }
__host__ __device__ __forceinline__ int perm32(int rho) { const int n = rho >> 4, i = rho & 15; return 8 * (i >> 2) + 4 * n + (i & 3); }

struct Unit { int pm, pn, g, nkt, mode, sidx; size_t ao, bo; };
struct Gemm { const bf16_t* A; const bf16_t* Bt; int lda, ldb; };

struct StaticOrder {
    int nN, nwgP, nDP, ntot, G, c, npair, pnsplit, s, sfirst; size_t tA, tB;
    __device__ void init(int N, int K, int lda, int ldb, int pnsplit_, int s_, int G_, int c_, int sfirst_ = 0, int brows = BM) { sfirst = sfirst_;   nN = N / BM; nwgP = 32 * nN; pnsplit = pnsplit_; s = s_; nDP = nwgP + pnsplit; ntot = nDP + (nN - pnsplit) * s; G = G_; c = c_; npair = K / (2 * BK);
        tA = (size_t)BM * lda * 2; tB = (size_t)brows * ldb * 2; }
    __device__ bool next(int i, Unit& u) const {
        int L = i * G + c;
        if (sfirst) { const int nsub = ntot - nDP; if (c < nsub) { const int pos = (c >> 3) & 1;
                if (i == pos) L = nDP + c; else { L = (i < pos ? i : i - 1) * G + c; if (L >= nDP) return false; } } else if (L >= nDP) return false; }
        if (L >= ntot) return false;
        u.g = 0; u.mode = 0; u.sidx = 0; u.nkt = 2 * npair;
        if (L < nwgP) {
            int wgid = L; { const int q = nwgP / NXCD, xcd = wgid % NXCD, off = wgid / NXCD; wgid = xcd * q + off; }
            const int nig = WGM * nN, gid = wgid / nig, fm = gid * WGM;
            u.pm = fm + ((wgid % nig) % WGM); u.pn = (wgid % nig) / WGM; u.ao = (size_t)u.pm * tA; u.bo = (size_t)u.pn * tB;
        } else if (L < nDP) { u.pm = 32; u.pn = L - nwgP; u.ao = 32 * tA; u.bo = (size_t)u.pn * tB; }
        else { const int L2 = L - nDP, t = L2 / s, part = L2 - t * s, p0 = npair * part / s, p1 = npair * (part + 1) / s;
            u.pm = 32; u.pn = pnsplit + t; u.nkt = 2 * (p1 - p0); u.mode = 1; u.sidx = part; u.ao = 32 * tA + (size_t)p0 * 256; u.bo = (size_t)u.pn * tB + (size_t)p0 * 256; }
        return true;
    }
};
struct PoolOrder {
    int G, c;
    __device__ void init(int G_, int c_) { G = G_; c = c_; }
    __device__ bool next(int i, Unit& u) const {
        const int L = i * G + c; if (L >= 4 * NPANEL * 2) return false;
        if (L < 256) { u.g = L >> 6; u.pm = (L & 63) >> 1; u.pn = L & 1; } else { const int L2 = L - 256; u.g = L2 >> 1; u.pm = 32; u.pn = L2 & 1; }
        u.nkt = PGRP / BK; u.mode = 0; u.sidx = 0;
        u.ao = ((size_t)u.pm * BM * DB + (size_t)u.g * PGRP) * 2; u.bo = ((size_t)u.g * PGRP + (size_t)u.pn * BM) * PGRP * 2; return true;
    }
};

struct EpiBf16 {
    static constexpr bool PERM = true; static constexpr int BMODE = 1; static constexpr int AMODE = 0;
    bf16_t* O; int ldc; int gcol; const float* bias; const float* scale; const float* rowss;
    __device__ __forceinline__ void operator()(const f32x4 (&acc)[2][2][4][2], const Unit& u, int wr, int wc, int fr, int fq) const {
        const int row0 = u.pm * BM + wr * 64 + fr; const int col0 = u.g * gcol + u.pn * BM + wc * 32 + 8 * fq;
        f32x4 bv[2][2], sv[2][2];
#pragma unroll
        for (int bj = 0; bj < 2; ++bj)
#pragma unroll
            for (int n = 0; n < 2; ++n) { bv[bj][n] = bias ? *(const f32x4*)(bias + col0 + bj * HALF + 4 * n) : (f32x4){0.f, 0.f, 0.f, 0.f};
                                          sv[bj][n] = scale ? *(const f32x4*)(scale + col0 + bj * HALF + 4 * n) : (f32x4){1.f, 1.f, 1.f, 1.f}; }
#pragma unroll
        for (int ai = 0; ai < 2; ++ai)
#pragma unroll
            for (int m = 0; m < 4; ++m) { bf16_t* rowp = O + (size_t)(row0 + ai * HALF + m * 16) * ldc + col0;
                const float rs = rowss ? 1.0f / sqrtf(rowss[row0 + ai * HALF + m * 16] * (1.0f / DM) + EPS) : 1.0f;
#pragma unroll
                for (int bj = 0; bj < 2; ++bj) { const f32x4 v0 = (acc[ai][bj][m][0] * rs + bv[bj][0]) * sv[bj][0], v1 = (acc[ai][bj][m][1] * rs + bv[bj][1]) * sv[bj][1];
                    u32x4 w; w.x = cvtpk(v0[0], v0[1]); w.y = cvtpk(v0[2], v0[3]); w.z = cvtpk(v1[0], v1[1]); w.w = cvtpk(v1[2], v1[3]);
                    *(u32x4*)(rowp + bj * HALF) = w; } }
    }
};
struct EpiUpU {
    static constexpr bool PERM = true; static constexpr int BMODE = 3; static constexpr int AMODE = 0; static constexpr bool PUBLISH = false;
    bf16_t* O; const float* rowss;
    __device__ __forceinline__ void operator()(const f32x4 (&acc)[2][2][4][2], const Unit& u, int wr, int wc, int fr, int fq) const {
        const int row0 = u.pm * BM + wr * 64 + fr, ch0 = u.pn * HALF + wc * 32 + 8 * fq;
#pragma unroll
        for (int ai = 0; ai < 2; ++ai)
#pragma unroll
            for (int m = 0; m < 4; ++m) { const int row = row0 + ai * HALF + m * 16; bf16_t* rowp = O + (size_t)row * NUP + ch0;
                const float rs = 1.0f / sqrtf(rowss[row] * (1.0f / DM) + EPS);
#pragma unroll
                for (int bj = 0; bj < 2; ++bj) { const f32x4 v0 = acc[ai][bj][m][0] * rs, v1 = acc[ai][bj][m][1] * rs;
                    *(u32x4*)(rowp + bj * DFF) = (u32x4){cvtpk(v0[0], v0[1]), cvtpk(v0[2], v0[3]), cvtpk(v1[0], v1[1]), cvtpk(v1[2], v1[3])}; } }
    }
};
__device__ __forceinline__ f32x4 dpp_shr1(f32x4 v) { f32x4 r;
#pragma unroll
    for (int i = 0; i < 4; ++i) r[i] = __int_as_float(__builtin_amdgcn_update_dpp(0, __float_as_int(v[i]), 0x111, 0xf, 0xf, false)); return r; }
struct EpiUpConv {
    static constexpr bool PERM = true; static constexpr int BMODE = 3; static constexpr int AMODE = 1; static constexpr bool PUBLISH = false;
    bf16_t* U; bf16_t* ACT; bf16_t* halo; const float* rowss; const float* cw; float* fout;
    __device__ __forceinline__ void stage(LAS unsigned char* dst, const Unit& u, int wid, int lane) const {
        if (wid < 3 && u.pm != 32) __builtin_amdgcn_global_load_lds((const unsigned*)(cw + (size_t)wid * NUP + (lane >> 5) * DFF + u.pn * HALF + 4 * (lane & 31)), (LAS unsigned*)(dst + wid * 1024), 16, 0, 0);
    }
    __device__ __forceinline__ void operator()(const f32x4 (&acc)[2][2][4][2], const Unit& u, int wr, int wc, int fr, int fq, const LAS float* wl) const {
        const int rb = u.pm * BM + wr * 64 + 4 * fr, ch0 = u.pn * HALF + wc * 32 + 8 * fq;
        if (u.pm == 32) {
            const f32x4 ss = *(const f32x4*)(rowss + rb);
#pragma unroll
            for (int m = 0; m < 4; ++m) { bf16_t* rowp = U + (size_t)(rb + m) * NUP + ch0;
                const float rs = __builtin_amdgcn_rsqf(ss[m] * (1.0f / DM) + EPS);
#pragma unroll
                for (int bj = 0; bj < 2; ++bj) { const f32x4 v0 = acc[0][bj][m][0] * rs, v1 = acc[0][bj][m][1] * rs;
                    *(u32x4*)(rowp + bj * DFF) = (u32x4){cvtpk(v0[0], v0[1]), cvtpk(v0[2], v0[3]), cvtpk(v1[0], v1[1]), cvtpk(v1[2], v1[3])}; } }
            return;
        }
        const bool f0 = fr == 0, f15 = fr == 15;
        const f32x4 ssq[2] = {*(const f32x4*)(rowss + rb), *(const f32x4*)(rowss + rb + HALF)};
        const LAS float* wlc = wl + wc * 32 + 8 * fq;
#pragma unroll
        for (int ai = 0; ai < 2; ++ai) {
            const int blk = ai * 2 + wr;
            const f32x4 ss = ssq[ai];
            f32x4 rs;
#pragma unroll
            for (int m = 0; m < 4; ++m) rs[m] = __builtin_amdgcn_rsqf(ss[m] * (1.0f / DM) + EPS);
#pragma unroll
            for (int n = 0; n < 2; ++n) {
                bf16_t* hb = halo + ((size_t)(u.pm * 4 + blk) * 4) * NUP + ch0 + 4 * n;
                f32x4 cg[4];
#pragma unroll
                for (int bj = 0; bj < 2; ++bj) {
                    f32x4 w[3];
#pragma unroll
                    for (int k = 0; k < 3; ++k) w[k] = *(const LAS f32x4*)(wlc + k * 256 + bj * 128 + 4 * n);
                    f32x4 x[4];
#pragma unroll
                    for (int m = 0; m < 4; ++m) x[m] = acc[ai][bj][m][n] * rs[m];
                    if (f0) { *(u32x2*)(hb + bj * DFF) = (u32x2){cvtpk(x[0][0], x[0][1]), cvtpk(x[0][2], x[0][3])}; *(u32x2*)(hb + (size_t)NUP + bj * DFF) = (u32x2){cvtpk(x[1][0], x[1][1]), cvtpk(x[1][2], x[1][3])}; }
                    if (f15) { *(u32x2*)(hb + (size_t)2 * NUP + bj * DFF) = (u32x2){cvtpk(x[2][0], x[2][1]), cvtpk(x[2][2], x[2][3])}; *(u32x2*)(hb + (size_t)3 * NUP + bj * DFF) = (u32x2){cvtpk(x[3][0], x[3][1]), cvtpk(x[3][2], x[3][3])};
                        if ((u.pm & 7) == 7 && blk == 3) { float* fo = fout + ((size_t)(u.pm >> 3) * 2) * NUP + bj * DFF + ch0 + 4 * n; *(f32x4*)fo = x[2]; *(f32x4*)(fo + NUP) = x[3]; } }
                    const f32x4 s2 = dpp_shr1(x[2]), s3 = dpp_shr1(x[3]);
                    if (bj == 0) {
                        cg[0] = s2 * w[0] + s3 * w[1] + x[0] * w[2];
                        cg[1] = s3 * w[0] + x[0] * w[1] + x[1] * w[2];
                        cg[2] = x[0] * w[0] + x[1] * w[1] + x[2] * w[2];
                        cg[3] = x[1] * w[0] + x[2] * w[1] + x[3] * w[2];
                        asm volatile("" ::: "memory");
                    } else {
#pragma unroll
                        for (int m = 0; m < 4; ++m) {
                            const f32x4 cu = (m == 0 ? s2 : m == 1 ? s3 : x[m - 2]) * w[0] + (m == 0 ? s3 : x[m > 0 ? m - 1 : 0]) * w[1] + x[m] * w[2];
                            f32x4 a;
#pragma unroll
                            for (int i = 0; i < 4; ++i) a[i] = cg[m][i] * __builtin_amdgcn_rcpf(1.0f + __expf(-cg[m][i])) * cu[i];
                            if (!(m < 2 && f0)) *(u32x2*)(ACT + (size_t)(rb + ai * HALF + m) * DFF + ch0 + 4 * n) = (u32x2){cvtpk(a[0], a[1]), cvtpk(a[2], a[3])};
                            asm volatile("" ::: "memory");
                        }
                    }
                }
                asm volatile("" ::: "memory");
            }
        }
    }
};
struct EpiResid {
    static constexpr bool PERM = true; static constexpr int BMODE = 1; static constexpr int AMODE = 0;
    const bf16_t* Hold; const float* igain; const float* rowf; bf16_t* H; const float* gain; float* rowss;
    __device__ __forceinline__ void operator()(const f32x4 (&acc)[2][2][4][2], const Unit& u, int wr, int wc, int fr, int fq) const {
        const int row0 = u.pm * BM + wr * 64 + fr, col0 = u.pn * BM + wc * 32 + 8 * fq;
        f32x4 gv[2][2], iv[2][2];
#pragma unroll
        for (int bj = 0; bj < 2; ++bj)
#pragma unroll
            for (int n = 0; n < 2; ++n) { gv[bj][n] = *(const f32x4*)(gain + col0 + bj * HALF + 4 * n); iv[bj][n] = *(const f32x4*)(igain + col0 + bj * HALF + 4 * n); }
        float rf[8];
#pragma unroll
        for (int g = 0; g < 8; ++g) rf[g] = rowf ? sqrtf(rowf[row0 + (g >> 2) * HALF + (g & 3) * 16] * (1.0f / DM) + EPS) : 1.0f;
#pragma unroll
        for (int ai = 0; ai < 2; ++ai)
#pragma unroll
            for (int m = 0; m < 4; ++m) { const int row = row0 + ai * HALF + m * 16;
                const size_t ro = (size_t)row * DM + col0;
                float ss = 0.f;
#pragma unroll
                for (int bj = 0; bj < 2; ++bj) {
                    const u32x4 w = *(const u32x4*)(Hold + ro + bj * HALF);
                    const f32x4 b0 = (f32x4){bflo(w.x), bfhi(w.x), bflo(w.y), bfhi(w.y)} * (iv[bj][0] * rf[ai * 4 + m]), b1 = (f32x4){bflo(w.z), bfhi(w.z), bflo(w.w), bfhi(w.w)} * (iv[bj][1] * rf[ai * 4 + m]);
                    const f32x4 v0 = b0 + acc[ai][bj][m][0], v1 = b1 + acc[ai][bj][m][1];
                    ss += (v0.x * v0.x + v0.y * v0.y) + (v0.z * v0.z + v0.w * v0.w) + (v1.x * v1.x + v1.y * v1.y) + (v1.z * v1.z + v1.w * v1.w);
                    const f32x4 h0 = v0 * gv[bj][0], h1 = v1 * gv[bj][1];
                    *(u32x4*)(H + ro + bj * HALF) = (u32x4){cvtpk(h0.x, h0.y), cvtpk(h0.z, h0.w), cvtpk(h1.x, h1.y), cvtpk(h1.z, h1.w)};
                }
                ss += __shfl_xor(ss, 16); ss += __shfl_xor(ss, 32); if (fq == 0) unsafeAtomicAdd(rowss + row, ss);
            }
    }
};

struct EpiQKV {
    static constexpr bool PERM = true; static constexpr int BMODE = 2; static constexpr int AMODE = 0;
    bf16_t* O; const float* bias; const float* rowss; const f32x4* rope; float* out;
    __device__ __forceinline__ void operator()(const f32x4 (&acc)[2][2][4][2], const Unit& u, int wr, int wc, int fr, int fq) const {
        const int hh = u.pn * 4 + wc, d0 = 8 * fq, colb = hh * HD + d0, row0 = u.pm * BM + wr * 64 + fr;
        f32x4 bv[2][2];
#pragma unroll
        for (int bj = 0; bj < 2; ++bj)
#pragma unroll
            for (int n = 0; n < 2; ++n) bv[bj][n] = *(const f32x4*)(bias + colb + 32 * bj + 4 * n);
#pragma unroll
        for (int ai = 0; ai < 2; ++ai)
#pragma unroll
            for (int m = 0; m < 4; ++m) { const int row = row0 + ai * HALF + m * 16;
                const float rs = 1.0f / sqrtf(rowss[row] * (1.0f / DM) + EPS);
                const bool samp = row >= MP; const int t = samp ? ((row - MP) & (TS - 1)) : (row & (TP - 1)), b = samp ? ((row - MP) >> 2) : (row >> 11);
                f32x4 x[2][2];
#pragma unroll
                for (int bj = 0; bj < 2; ++bj)
#pragma unroll
                    for (int n = 0; n < 2; ++n) x[bj][n] = acc[ai][bj][m][n] * rs + bv[bj][n];
                if (hh < NH + NKV) {
                    const f32x4* cs = rope + ((size_t)((row < MR) ? (samp ? TP + t : t) : 0) * 32 + d0) / 2;
#pragma unroll
                    for (int n = 0; n < 2; ++n) { const f32x4 c01 = cs[2 * n], c23 = cs[2 * n + 1]; const f32x4 a = x[0][n], bb = x[1][n];
                        x[0][n] = (f32x4){a.x * c01.x - bb.x * c01.y, a.y * c01.z - bb.y * c01.w, a.z * c23.x - bb.z * c23.y, a.w * c23.z - bb.w * c23.w};
                        x[1][n] = (f32x4){bb.x * c01.x + a.x * c01.y, bb.y * c01.z + a.y * c01.w, bb.z * c23.x + a.z * c23.y, bb.w * c23.z + a.w * c23.w}; }
                }
                bf16_t* op = O + (size_t)row * NQKV + colb;
#pragma unroll
                for (int bj = 0; bj < 2; ++bj) *(u32x4*)(op + 32 * bj) = (u32x4){cvtpk(x[bj][0].x, x[bj][0].y), cvtpk(x[bj][0].z, x[bj][0].w), cvtpk(x[bj][1].x, x[bj][1].y), cvtpk(x[bj][1].z, x[bj][1].w)};
                if (hh >= NH && row < MR) {
                    const int kvh = (hh - NH) & 7; const bool isv = hh >= NH + NKV; float* o = nullptr;
                    if (!samp) { if (t >= TP - WIN) o = out + (isv ? O_V_P : O_K_P) + (((size_t)b * WIN + (t - (TP - WIN))) * NKV + kvh) * HD + d0; }
                    else o = out + (isv ? O_V_S : O_K_S) + (((size_t)b * WIN + (WIN - TS + t)) * NKV + kvh) * HD + d0;
                    if (o) { *(f32x4*)o = x[0][0]; *(f32x4*)(o + 4) = x[0][1]; *(f32x4*)(o + 32) = x[1][0]; *(f32x4*)(o + 36) = x[1][1]; }
                }
            }
    }
};

template <class Epi, class Sched>
__device__ __forceinline__ void gemm_phase(LAS unsigned char* lds, const Gemm g, const Sched& S, const Epi& E, float* slab, int slabN, int slabPn0, unsigned* pubcnt = nullptr, int ibeg = 0, int iend = 1 << 30) {
    const int tid = threadIdx.x, wid = __builtin_amdgcn_readfirstlane(tid >> 6), lane = tid & 63, wr = wid >> 2, wc = wid & 3, fr = lane & 15, fq = lane >> 4;
    unsigned voffA[2], voffB[2];
#pragma unroll
    for (int i = 0; i < 2; ++i) { int R, C; stage_rc(tid * 16 + i * 8192, R, C);
        const int Rb = Epi::BMODE == 2 ? (64 * (R >> 5) + perm32(R & 31)) : Epi::BMODE != 0 ? ((R & ~31) + perm32(R & 31)) : R;
        const int Ra = Epi::AMODE != 0 ? ((R & ~63) + 4 * (R & 15) + ((R >> 4) & 3)) : R;
        voffA[i] = (unsigned)(Ra * g.lda + C) * 2u; voffB[i] = (unsigned)(Rb * g.ldb + C) * 2u; }
    const size_t kstep = (size_t)(BK * 2);
    const size_t hstepA = (size_t)HALF * g.lda * 2, hstepB = (size_t)(Epi::BMODE == 3 ? DFF : Epi::BMODE == 2 ? 32 : HALF) * g.ldb * 2;
    const unsigned ldsw = (unsigned)wid * 1024u;
    const int aoff = lds_byte(wr * 64 + fr, fq * 8), boff = lds_byte(wc * 32 + fr, fq * 8);
#define PG8_SA(b, h) (((b) * 2 + (h)) * HTB)
#define PG8_SB(b, h) ((4 + (b) * 2 + (h)) * HTB)
#define PG8_STAGE(bufoff, gbase, voff) do { _Pragma("unroll") for (int _i = 0; _i < 2; ++_i) \
        __builtin_amdgcn_global_load_lds((const unsigned*)((const char*)(gbase) + (voff)[_i]), (LAS unsigned*)(lds + (bufoff) + ldsw + _i * 8192), 16, 0, 0); } while (0)
#define PG8_LDA(dst, b, h) do { _Pragma("unroll") for (int m = 0; m < 4; ++m) _Pragma("unroll") for (int k = 0; k < 2; ++k) dst[m][k] = *(const LAS bf16x8*)(lds + PG8_SA(b, h) + aoff + m * 2048 + k * 1024); } while (0)
#define PG8_LDB(dst, b, h) do { _Pragma("unroll") for (int n = 0; n < 2; ++n) _Pragma("unroll") for (int k = 0; k < 2; ++k) dst[n][k] = *(const LAS bf16x8*)(lds + PG8_SB(b, h) + boff + n * 2048 + k * 1024); } while (0)
#define PG8_MMA(ai, bj, At, Bt) do { __builtin_amdgcn_s_setprio(1); _Pragma("unroll") for (int m = 0; m < 4; ++m) _Pragma("unroll") for (int n = 0; n < 2; ++n) _Pragma("unroll") for (int k = 0; k < 2; ++k) \
        acc[ai][bj][m][n] = __builtin_amdgcn_mfma_f32_16x16x32_bf16(Bt[n][k], At[m][k], acc[ai][bj][m][n], 0, 0, 0); __builtin_amdgcn_s_setprio(0); } while (0)
#define PG8_WAIT_V(n) asm volatile("s_waitcnt vmcnt(" #n ")" ::: "memory")
#define PG8_WAIT_L(n) asm volatile("s_waitcnt lgkmcnt(" #n ")" ::: "memory")
#define PG8_BAR __builtin_amdgcn_s_barrier()
#define PG8_SCHED __builtin_amdgcn_sched_barrier(0)
    Unit cur, nxt; int ui = ibeg;
    if (ibeg >= iend || !S.next(ibeg, cur)) return;
    f32x4 acc[2][2][4][2];
#pragma unroll
    for (int a = 0; a < 2; ++a)
#pragma unroll
        for (int b = 0; b < 2; ++b)
#pragma unroll
            for (int m = 0; m < 4; ++m)
#pragma unroll
                for (int n = 0; n < 2; ++n) acc[a][b][m][n] = (f32x4){0.f, 0.f, 0.f, 0.f};
    bf16x8 At[4][2], B0[2][2], B1[2][2];
    const char* cA = (const char*)g.A + cur.ao; const char* cB = (const char*)g.Bt + cur.bo;
    PG8_STAGE(PG8_SB(0, 0), cB, voffB); PG8_STAGE(PG8_SB(0, 1), cB + hstepB, voffB); PG8_STAGE(PG8_SA(0, 0), cA, voffA); PG8_STAGE(PG8_SA(0, 1), cA + hstepA, voffA);
    if (wr == 1) PG8_BAR;
    PG8_WAIT_V(2); PG8_BAR;
    PG8_STAGE(PG8_SB(1, 0), cB + kstep, voffB); PG8_STAGE(PG8_SA(1, 0), cA + kstep, voffA); PG8_STAGE(PG8_SB(1, 1), cB + hstepB + kstep, voffB);
    PG8_WAIT_V(6); PG8_BAR;
    for (;;) {
        if constexpr (Epi::AMODE != 0) E.stage(lds + WLDS_OFF + (ui & 1) * 3072, cur, wid, lane);
        const bool has_next = (ui + 1 < iend) && S.next(ui + 1, nxt);
        const char* nA = has_next ? (const char*)g.A + nxt.ao : cA; const char* nB = has_next ? (const char*)g.Bt + nxt.bo : cB;
        const int nt = cur.nkt; const bool full = cur.pm != 32;
        for (int t = 0; t < nt; t += 2) {
            const bool last = (t == nt - 2);
            const char* a1 = cA + (size_t)(t + 1) * kstep;
            const char* a2 = last ? nA : cA + (size_t)(t + 2) * kstep; const char* b2 = last ? nB : cB + (size_t)(t + 2) * kstep;
            const char* a3 = a2 + kstep; const char* b3 = b2 + kstep;
            PG8_LDB(B0, 0, 0); PG8_LDB(B1, 0, 1); PG8_SCHED; PG8_LDA(At, 0, 0); PG8_STAGE(PG8_SA(1, 1), a1 + hstepA, voffA);
            PG8_WAIT_V(8); PG8_WAIT_L(0); PG8_BAR; PG8_MMA(0, 0, At, B0); PG8_MMA(0, 1, At, B1); PG8_BAR; PG8_SCHED;
            PG8_LDA(At, 0, 1); PG8_STAGE(PG8_SB(0, 0), b2, voffB); PG8_STAGE(PG8_SB(0, 1), b2 + hstepB, voffB); PG8_STAGE(PG8_SA(0, 0), a2, voffA);
            PG8_WAIT_V(8); PG8_WAIT_L(0); PG8_BAR; if (full) { PG8_MMA(1, 0, At, B0); PG8_MMA(1, 1, At, B1); } PG8_BAR; PG8_SCHED;
            PG8_LDB(B0, 1, 0); PG8_LDB(B1, 1, 1); PG8_SCHED; PG8_LDA(At, 1, 0); PG8_STAGE(PG8_SA(0, 1), a2 + hstepA, voffA);
            PG8_WAIT_V(8); PG8_WAIT_L(0); PG8_BAR; PG8_MMA(0, 0, At, B0); PG8_MMA(0, 1, At, B1); PG8_BAR; PG8_SCHED;
            PG8_LDA(At, 1, 1); PG8_STAGE(PG8_SB(1, 0), b3, voffB); PG8_STAGE(PG8_SB(1, 1), b3 + hstepB, voffB); PG8_STAGE(PG8_SA(1, 0), a3, voffA);
            PG8_WAIT_V(8); PG8_WAIT_L(0); PG8_BAR; if (full) { PG8_MMA(1, 0, At, B0); PG8_MMA(1, 1, At, B1); } PG8_BAR; PG8_SCHED;
        }
        if (wr == 0) PG8_BAR;
        if (cur.mode) {
            static_assert(Epi::PERM, "slab store assumes the lane's 8 columns are contiguous");
            bf16_t* sp = (bf16_t*)slab + ((size_t)cur.sidx * 128 + wr * 64 + (Epi::AMODE != 0 ? 4 * fr : fr)) * slabN + (cur.pn - slabPn0) * BM + wc * 32 + 8 * fq;
#pragma unroll
            for (int m = 0; m < 4; ++m)
#pragma unroll
                for (int bj = 0; bj < 2; ++bj) { bf16_t* dp = sp + (size_t)(Epi::AMODE != 0 ? m : m * 16) * slabN + bj * HALF;
                    const f32x4 a0 = acc[0][bj][m][0], a1 = acc[0][bj][m][1];
                    const u32x4 pv = {cvtpk(a0.x, a0.y), cvtpk(a0.z, a0.w), cvtpk(a1.x, a1.y), cvtpk(a1.z, a1.w)};
                    if (pubcnt) asm volatile("global_store_dwordx4 %0, %1, off sc1" :: "v"(dp), "v"(pv) : "memory");
                    else *(u32x4*)dp = pv; }
            if (pubcnt) { PG8_WAIT_V(0); PG8_BAR; if (tid == 0) __hip_atomic_fetch_add(pubcnt, 1u, __ATOMIC_RELAXED, __HIP_MEMORY_SCOPE_AGENT); }
        } else { if constexpr (Epi::AMODE != 0) E(acc, cur, wr, wc, fr, fq, (const LAS float*)(lds + WLDS_OFF + (ui & 1) * 3072)); else E(acc, cur, wr, wc, fr, fq); }
        if (!has_next) break;
#pragma unroll
        for (int a = 0; a < 2; ++a)
#pragma unroll
            for (int b = 0; b < 2; ++b)
#pragma unroll
                for (int m = 0; m < 4; ++m)
#pragma unroll
                    for (int n = 0; n < 2; ++n) acc[a][b][m][n] = (f32x4){0.f, 0.f, 0.f, 0.f};
        cur = nxt; cA = nA; cB = nB; ++ui;
        if (wr == 1) PG8_BAR;
    }
    PG8_WAIT_V(0);
    PG8_BAR;
#undef PG8_SA
#undef PG8_SB
#undef PG8_STAGE
#undef PG8_LDA
#undef PG8_LDB
#undef PG8_MMA
#undef PG8_WAIT_V
#undef PG8_WAIT_L
#undef PG8_BAR
#undef PG8_SCHED
}
}

#define XB_TMO      128
#define XB_XCNT(j)  (256  + 64 * (j))
#define XB_XSUB(j)  (1280 + 64 * (j))
#define XB_XGEN(j)  (2304 + 64 * (j))
#define XB_TOP      3328
#define XB_TOPGEN   3392
#define XCD_BAR_WORDS 3456
#define XB_SPIN_CAP (1u << 18)
__device__ __forceinline__ unsigned xb_ld(unsigned* p)              { return __hip_atomic_load(p, __ATOMIC_RELAXED, __HIP_MEMORY_SCOPE_AGENT); }
__device__ __forceinline__ unsigned xb_add(unsigned* p, unsigned v) { return __hip_atomic_fetch_add(p, v, __ATOMIC_RELAXED, __HIP_MEMORY_SCOPE_AGENT); }
__device__ __forceinline__ unsigned xb_xcc_id() { return (unsigned)__builtin_amdgcn_s_getreg((3 << 11) | 20) & 0xFu; }
#define XB_SPIN(cond, bar) do { unsigned _sp = 0; while (cond) { __builtin_amdgcn_s_sleep(1); \
    if ((++_sp & 255u) == 0u) { if (xb_ld(&(bar)[XB_TMO])) break; if (_sp > XB_SPIN_CAP) { atomicAdd(&(bar)[XB_TMO], 1u); break; } } } } while (0)
struct XcdBarrier { unsigned* bar; unsigned x; volatile LAS unsigned* st; };
__device__ __forceinline__ XcdBarrier xcd_barrier_post(unsigned* bar, volatile LAS unsigned* st) {
    XcdBarrier b; b.bar = bar; b.x = xb_xcc_id(); b.st = st;
    if (threadIdx.x == 0) (void)xb_add(&bar[XB_XCNT(b.x)], 1u);
    return b;
}
__device__ __forceinline__ void xcd_barrier_complete(unsigned* bar, unsigned x, unsigned& nloc, unsigned& nx) {
    const unsigned G = gridDim.x * gridDim.y * gridDim.z;
    unsigned sum, cnt, mine, sp = 0u;
    for (;;) {
        sum = 0u; cnt = 0u; mine = 0u;
#pragma unroll
        for (unsigned j = 0; j < 16; ++j) { const unsigned c = xb_ld(&bar[XB_XCNT(j)]); sum += c; cnt += (c > 0u) ? 1u : 0u; mine = (j == x) ? c : mine; }
        if (sum == G) break;
        __builtin_amdgcn_s_sleep(1);
        if ((++sp & 255u) == 0u) { if (xb_ld(&bar[XB_TMO])) break; if (sp > XB_SPIN_CAP) { atomicAdd(&bar[XB_TMO], 1u); break; } }
    }
    nloc = mine > 0u ? mine : 1u; nx = cnt > 0u ? cnt : 1u;
}
__device__ __forceinline__ void xcd_barrier(const XcdBarrier& b) {
    asm volatile("s_waitcnt vmcnt(0)" ::: "memory");
    __syncthreads();
    if (threadIdx.x == 0) {
        unsigned* bar = b.bar;
        __builtin_amdgcn_s_waitcnt(0);
        unsigned nloc = b.st[0], nx = b.st[1];
        if (nloc == 0u) { xcd_barrier_complete(bar, b.x, nloc, nx); b.st[0] = nloc; b.st[1] = nx; }
        const unsigned old = xb_add(&bar[XB_XSUB(b.x)], 1u);
        const unsigned gen = old / nloc;
        if (old + 1u == (gen + 1u) * nloc) {
            __builtin_amdgcn_fence(__ATOMIC_RELEASE, "agent");
            asm volatile("s_waitcnt vmcnt(0)" ::: "memory");
            const unsigned og = xb_add(&bar[XB_TOP], 1u);
            const unsigned tg = og / nx;
            if (og + 1u == (tg + 1u) * nx) xb_add(&bar[XB_TOPGEN], 1u);
            else XB_SPIN(xb_ld(&bar[XB_TOPGEN]) == tg, bar);
            __builtin_amdgcn_fence(__ATOMIC_ACQUIRE, "agent");
            xb_add(&bar[XB_XGEN(b.x)], 1u);
            asm volatile("s_waitcnt vmcnt(0)" ::: "memory");
        } else {
            XB_SPIN(xb_ld(&bar[XB_XGEN(b.x)]) == gen, bar);
            __builtin_amdgcn_fence(__ATOMIC_ACQUIRE, "agent");
            asm volatile("s_waitcnt vmcnt(0)" ::: "memory");
        }
    }
    __syncthreads();
}

struct Params;
__device__ __forceinline__ bool bg_step(const Params& p, LAS unsigned char* lds, volatile LAS unsigned* st);
__device__ __forceinline__ void xcd_barrier_bg(const XcdBarrier& b, const Params& p, LAS unsigned char* lds) {
    volatile LAS unsigned* st = b.st;
    asm volatile("s_waitcnt vmcnt(0)" ::: "memory");
    __syncthreads();
    unsigned* bar = b.bar;
    if (threadIdx.x == 0) {
        __builtin_amdgcn_s_waitcnt(0);
        unsigned nloc = st[0], nx = st[1];
        if (nloc == 0u) { xcd_barrier_complete(bar, b.x, nloc, nx); st[0] = nloc; st[1] = nx; }
        const unsigned old = xb_add(&bar[XB_XSUB(b.x)], 1u);
        const unsigned gen = old / nloc;
        const bool leader = old + 1u == (gen + 1u) * nloc;
        st[2] = leader ? 1u : 0u; st[3] = gen;
        if (leader) {
            __builtin_amdgcn_fence(__ATOMIC_RELEASE, "agent");
            asm volatile("s_waitcnt vmcnt(0)" ::: "memory");
            const unsigned og = xb_add(&bar[XB_TOP], 1u);
            const unsigned tg = og / nx;
            if (og + 1u == (tg + 1u) * nx) xb_add(&bar[XB_TOPGEN], 1u);
            else XB_SPIN(xb_ld(&bar[XB_TOPGEN]) == tg, bar);
            __builtin_amdgcn_fence(__ATOMIC_ACQUIRE, "agent");
            xb_add(&bar[XB_XGEN(b.x)], 1u);
            asm volatile("s_waitcnt vmcnt(0)" ::: "memory");
        }
    }
    __syncthreads();
    if (st[2] == 0u) {
        const unsigned gen = st[3];
        __syncthreads();
        for (;;) {
            if (threadIdx.x == 0) st[4] = (xb_ld(&bar[XB_XGEN(b.x)]) != gen) ? 1u : 0u;
            __syncthreads();
            const bool rel = st[4] != 0u;
            __syncthreads();
            if (rel) break;
            if (!bg_step(p, lds, st)) {
                if (threadIdx.x == 0) XB_SPIN(xb_ld(&bar[XB_XGEN(b.x)]) == gen, bar);
                break; }
        }
        if (threadIdx.x == 0) {
            asm volatile("s_waitcnt vmcnt(0)" ::: "memory");
            __builtin_amdgcn_fence(__ATOMIC_ACQUIRE, "agent");
            asm volatile("s_waitcnt vmcnt(0)" ::: "memory");
        }
    }
    __syncthreads();
}

struct Params { const float* in[22]; float* out; unsigned char* ws; int ph_lo, ph_hi; };
enum { I_XP = 0, I_XS, I_SCONV, I_SPOOL, I_CK, I_CV, I_SFFN, I_NMIX, I_WIN, I_CONVA, I_WPOOL, I_PSCALE, I_WOUT, I_WQKV, I_BQKV, I_SINKS, I_WO, I_NFFN, I_WUP, I_CONVF, I_WDN, I_NFIN };

__device__ __forceinline__ void slab_sum8(const float* slab, int N, int s, int srow, int col, float (&v)[8]) {
    const float* sp = slab + (size_t)srow * N + col;
    f32x4 a = {0.f, 0.f, 0.f, 0.f}, b = {0.f, 0.f, 0.f, 0.f};
#pragma unroll 4
    for (int q = 0; q < s; ++q) { a += *(const f32x4*)sp; b += *(const f32x4*)(sp + 4); sp += (size_t)128 * N; }
    v[0] = a.x; v[1] = a.y; v[2] = a.z; v[3] = a.w; v[4] = b.x; v[5] = b.y; v[6] = b.z; v[7] = b.w;
}
constexpr int S_IN = 8, S_RES = 16, S_UP = 11, UP_PNSPLIT = 64;
__device__ __forceinline__ void ld_proj8(const bf16_t* PROJ, const float*, int row, int col, float (&v)[8]) { load8(PROJ + (size_t)row * NIN + col, v); }
__device__ __forceinline__ void ld_u8(const bf16_t* U, const float*, const float*, int row, int col, float (&v)[8]) { load8(U + (size_t)row * NUP + col, v); }

constexpr int TSCR = 64 * 65 * 4;
__device__ __forceinline__ void p0_transpose_item(const float* W, int K, int N, bf16_t* WT, LAS float* scr, int item, int lane) {
    const int nblk = N / 64, kb = item / nblk, nb = item % nblk, k0 = 64 * kb, n0 = 64 * nb;
    const int lr = lane >> 4, lc = (lane & 15) * 4;
    f32x4 tv[16];
#pragma unroll
    for (int i = 0; i < 16; ++i) tv[i] = __builtin_nontemporal_load((const f32x4*)(W + (size_t)(k0 + 4 * i + lr) * N + n0 + lc));
#pragma unroll
    for (int i = 0; i < 16; ++i) { LAS float* d = scr + (4 * i + lr) * 65 + lc; d[0] = tv[i].x; d[1] = tv[i].y; d[2] = tv[i].z; d[3] = tv[i].w; }
    asm volatile("s_waitcnt lgkmcnt(0)" ::: "memory");
    const int c = lane & 7, nl = lane >> 3;
#pragma unroll
    for (int j = 0; j < 8; ++j) { const int n = nl + 8 * j; const LAS float* s = scr + (8 * c) * 65 + n;
        u32x4 o; o.x = cvtpk(s[0 * 65], s[1 * 65]); o.y = cvtpk(s[2 * 65], s[3 * 65]); o.z = cvtpk(s[4 * 65], s[5 * 65]); o.w = cvtpk(s[6 * 65], s[7 * 65]);
        __builtin_nontemporal_store(o, (u32x4*)(WT + (size_t)(n0 + n) * K + k0 + 8 * c)); }
    asm volatile("s_waitcnt lgkmcnt(0)" ::: "memory");
}
constexpr int CI_IN = (DM / 64) * (NIN / 64), CI_PL = (PGRP / 64) * (PGRP / 64), CI_SQ = (DM / 64) * (DM / 64), CI_QKV = (DM / 64) * (NQKV / 64), CI_UP = (DM / 64) * (NUP / 64), CI_DN = (DFF / 64) * (DM / 64);
constexpr int CJ0 = 0, CJ1 = CI_IN, CJ2 = CJ1 + 4 * CI_PL + CI_SQ + CI_UP, CJ3 = CJ2 + CI_DN, CJ4 = CJ3 + CI_QKV + CI_SQ + CI_UP + CI_DN;
__device__ __forceinline__ void convert_one(const Params& p, LAS float* scr, int it, int lane) {
    unsigned char* ws = p.ws; int r = it;
    if (r < CI_IN) { p0_transpose_item(p.in[I_WIN], DM, NIN, (bf16_t*)(ws + WS_WIN), scr, r, lane); return; } r -= CI_IN;
    if (r < 4 * CI_PL) { const int g = r / CI_PL; p0_transpose_item(p.in[I_WPOOL] + (size_t)g * PGRP * PGRP, PGRP, PGRP, (bf16_t*)(ws + WS_WPOOL) + (size_t)g * PGRP * PGRP, scr, r % CI_PL, lane); return; } r -= 4 * CI_PL;
    if (r < CI_SQ) { p0_transpose_item(p.in[I_WOUT], DM, DM, (bf16_t*)(ws + WS_WOUT), scr, r, lane); return; } r -= CI_SQ;
    if (r < CI_UP) { p0_transpose_item(p.in[I_WUP], DM, NUP, (bf16_t*)(ws + WS_WUP), scr, r, lane); return; } r -= CI_UP;
    if (r < CI_DN) { p0_transpose_item(p.in[I_WDN], DFF, DM, (bf16_t*)(ws + WS_WDN), scr, r, lane); return; } r -= CI_DN;
    if (r < CI_QKV) { p0_transpose_item(p.in[I_WQKV], DM, NQKV, (bf16_t*)(ws + WS_WQKV), scr, r, lane); return; } r -= CI_QKV;
    if (r < CI_SQ) { p0_transpose_item(p.in[I_WO], DM, DM, (bf16_t*)(ws + WS_WO), scr, r, lane); return; } r -= CI_SQ;
    if (r < CI_UP) { p0_transpose_item(p.in[I_WUP] + (size_t)DM * NUP, DM, NUP, (bf16_t*)(ws + WS_WUP) + WUP_STRIDE, scr, r, lane); return; } r -= CI_UP;
    p0_transpose_item(p.in[I_WDN] + (size_t)DFF * DM, DFF, DM, (bf16_t*)(ws + WS_WDN) + WDN_STRIDE, scr, r, lane);
}
__device__ __forceinline__ void convert_items(const Params& p, LAS unsigned char* lds, int G, int a, int b) {
    const int tid = threadIdx.x, lane = tid & 63, wave = __builtin_amdgcn_readfirstlane(tid >> 6);
    LAS float* scr = (LAS float*)(lds + wave * TSCR);
    const int gw = blockIdx.x * NWAVES + wave, NGW = G * NWAVES;
    for (int it = a + gw; it < b; it += NGW) convert_one(p, scr, it, lane);
    asm volatile("s_waitcnt vmcnt(0)" ::: "memory"); __syncthreads();
}
constexpr int BQ0 = CI_IN + 4 * CI_PL + CI_SQ;
constexpr int BQ_UP0 = BQ0 + CI_UP, BQ_DN0 = BQ_UP0 + CI_DN, BQ_QKV = BQ_DN0 + CI_QKV, BQ_O = BQ_QKV + CI_SQ, BQ_UP1 = BQ_O + CI_UP, BQ_DN1 = BQ_UP1 + CI_DN;
static_assert(BQ_DN1 == CJ4, "queue covers every remaining item");
constexpr int CW_BGQ = 12288;
__device__ __forceinline__ bool bg_step(const Params& p, LAS unsigned char* lds, volatile LAS unsigned* st) {
    unsigned* ctr = (unsigned*)(p.ws + WS_CTL) + CW_BGQ;
    if (threadIdx.x == 0) st[12] = __hip_atomic_fetch_add(ctr, 1u, __ATOMIC_RELAXED, __HIP_MEMORY_SCOPE_AGENT);
    __syncthreads();
    const int it0 = BQ0 + 8 * (int)st[12];
    __syncthreads();
    if (it0 >= CJ4) return false;
    const int lane = threadIdx.x & 63, wave = __builtin_amdgcn_readfirstlane(threadIdx.x >> 6);
    if (it0 + wave < CJ4) convert_one(p, (LAS float*)(lds + wave * TSCR), it0 + wave, lane);
    return true;
}
__device__ __forceinline__ void bg_drain(const Params& p, LAS unsigned char* lds, volatile LAS unsigned* st, int upto) {
    unsigned* ctr = (unsigned*)(p.ws + WS_CTL) + CW_BGQ;
    for (;;) {
        if (threadIdx.x == 0) st[13] = __hip_atomic_load(ctr, __ATOMIC_RELAXED, __HIP_MEMORY_SCOPE_AGENT);
        __syncthreads();
        const bool done = BQ0 + 8 * (int)st[13] >= upto;
        __syncthreads();
        if (done || !bg_step(p, lds, st)) break;
    }
}
__device__ __forceinline__ void prologue_phase(const Params& p, LAS unsigned char* lds, int G) {
    const int tid = threadIdx.x;
    unsigned char* ws = p.ws;
    convert_items(p, lds, G, CJ0, BG_CONV ? BQ0 : CJ4);
    for (int i = blockIdx.x * NTHR + tid; i < 4 * MPAD; i += G * NTHR) ((float*)(ws + WS_ROWSS))[i] = 0.f;
    for (int i = blockIdx.x * NTHR + tid; i < 4 * DM; i += G * NTHR) { const int k = i / DM, c = i - k * DM;
        ((float*)(ws + WS_IGAIN))[i] = 1.0f / (k == 0 ? p.in[I_NFFN][c] : k == 1 ? p.in[I_NMIX][DM + c] : k == 2 ? p.in[I_NFFN][DM + c] : p.in[I_NMIX][c]); }
    f32x2* rope = (f32x2*)(ws + WS_ROPE);
    for (int i = blockIdx.x * NTHR + tid; i < (TP + TS) * 32; i += G * NTHR) {
        const int pi = i >> 5, d = i & 31; const int pos = pi < TP ? pi : PAST + (pi - TP);
        const float inv = (float)exp2(-(double)d * (13.287712379549449 / 32.0));
        const float ang = (float)pos * inv;
        const double a = (double)ang, kq = __builtin_rint(a * 0.63661977236758134), rr = a - kq * 1.5707963267948966, r2 = rr * rr;
        const double sn = rr * (1.0 + r2 * (-1.0 / 6 + r2 * (1.0 / 120 + r2 * (-1.0 / 5040 + r2 * (1.0 / 362880 + r2 * (-1.0 / 39916800 + r2 * (1.0 / 6227020800.0)))))));
        const double cs = 1.0 + r2 * (-0.5 + r2 * (1.0 / 24 + r2 * (-1.0 / 720 + r2 * (1.0 / 40320 + r2 * (-1.0 / 3628800 + r2 * (1.0 / 479001600.0 + r2 * (-1.0 / 87178291200.0)))))));
        const int qd = (int)((long long)kq & 3);
        const double c = qd == 0 ? cs : qd == 1 ? -sn : qd == 2 ? -cs : sn, s = qd == 0 ? sn : qd == 1 ? cs : qd == 2 ? -sn : -cs;
        rope[i] = (f32x2){(float)c, (float)s};
    }
}

template <int MODE> __device__ __forceinline__ void norm_phase(const Params& p, const float* gain, int G) {
    const int tid = threadIdx.x, lane = tid & 63, wave = __builtin_amdgcn_readfirstlane(tid >> 6);
    const int gw = blockIdx.x * NWAVES + wave, NGW = G * NWAVES;
    float* X = (float*)(p.ws + WS_X); bf16_t* H = (bf16_t*)(p.ws + WS_H); const float* slab = (const float*)(p.ws + WS_SLAB);
    const int nlist = MP + ((MODE == 2) ? 0 : (MPAD - MR));
    for (int i = gw; i < nlist + MS * 16; i += NGW) {
        int r;
        if (i < MP) r = i; else if (i < nlist) r = MR + (i - MP); else { if ((i - nlist) & 15) continue; r = MP + ((i - nlist) >> 4); }
        if (r >= MR) {
            u32x2* o = (u32x2*)(H + (size_t)r * DM) + lane;
#pragma unroll
            for (int j = 0; j < 16; ++j) o[64 * j] = (u32x2){0u, 0u};
            continue;
        }
        if (MODE == 2 && r < MP) {
            const float rs = 1.0f / sqrtf(((const float*)(p.ws + WS_ROWSS))[3 * MPAD + r] * (1.0f / DM) + EPS);
            const u32x4* hr = (const u32x4*)(H + (size_t)r * DM) + lane; f32x4* o = (f32x4*)(p.out + O_Y + (size_t)r * DM) + 2 * lane;
            u32x4 w[8];
#pragma unroll
            for (int j = 0; j < 8; ++j) w[j] = hr[64 * j];
#pragma unroll
            for (int j = 0; j < 8; ++j) { o[128 * j] = (f32x4){bflo(w[j].x), bfhi(w[j].x), bflo(w[j].y), bfhi(w[j].y)} * rs; o[128 * j + 1] = (f32x4){bflo(w[j].z), bfhi(w[j].z), bflo(w[j].w), bfhi(w[j].w)} * rs; }
            continue;
        }
        const float* src = (MODE == 0) ? (r < MP ? p.in[I_XP] + (size_t)r * DM : p.in[I_XS] + (size_t)(r - MP) * DM) : X + (size_t)r * DM;
        const f32x4* xr = (const f32x4*)src + lane;
        f32x4 v[16]; float ss = 0.f;
#pragma unroll
        for (int j = 0; j < 16; ++j) v[j] = xr[64 * j];
        if (r >= MP) {
            f32x4* xw = (f32x4*)(X + (size_t)r * DM) + lane;
            if (MODE == 1) {
                const f32x4* sp = (const f32x4*)(slab + (size_t)(r - MP) * DM) + lane;
                for (int q = 0; q < S_RES; ++q) {
#pragma unroll
                    for (int j = 0; j < 16; ++j) v[j] += sp[64 * j];
                    sp += (size_t)128 * DM / 4; } }
            if (MODE != 2) {
#pragma unroll
                for (int j = 0; j < 16; ++j) xw[64 * j] = v[j]; }
        }
#pragma unroll
        for (int j = 0; j < 16; ++j) ss += (v[j].x * v[j].x + v[j].y * v[j].y) + (v[j].z * v[j].z + v[j].w * v[j].w);
        const float sst = wave_sum(ss);
        if (MODE == 0 && lane == 0) ((float*)(p.ws + WS_ROWSS))[4 * MPAD + r] = sst;
        const float rs = 1.0f / sqrtf(sst * (1.0f / DM) + EPS);
        const f32x4* gr = (const f32x4*)gain + lane;
        if (MODE == 2) { f32x4* o = (f32x4*)(p.out + O_Y + (size_t)r * DM) + lane;
#pragma unroll
            for (int j = 0; j < 16; ++j) { const f32x4 g4 = gr[64 * j]; o[64 * j] = v[j] * rs * g4; }
        } else { u32x2* o = (u32x2*)(H + (size_t)r * DM) + lane;
#pragma unroll
            for (int j = 0; j < 16; ++j) { const f32x4 g4 = gr[64 * j]; const f32x4 y = v[j] * rs * g4; o[64 * j] = (u32x2){cvtpk(y.x, y.y), cvtpk(y.z, y.w)}; }
        }
    }
}

template <int R, bool SAMP> __device__ __forceinline__ void conv_task(const Params& p, int row0, int b, int t0, int c0) {
    const bf16_t* PROJ = (const bf16_t*)(p.ws + WS_PROJ); bf16_t* CAT = (bf16_t*)(p.ws + WS_CAT); const float* slab = (const float*)(p.ws + WS_SLAB);
    const float* cw = p.in[I_CONVA]; float* out = p.out;
    float g[R + 2][8], gb[R][8], w[3][8];
#pragma unroll
    for (int k = 0; k < 3; ++k) loadf8(cw + (size_t)k * DA + c0, w[k]);
#pragma unroll
    for (int i = 0; i < R + 2; ++i) {
        const int tt = t0 + i - 2;
        if (tt >= 0) { float gc[8], xa[8]; ld_proj8(PROJ, slab, row0 + i - 2, DA + c0, gc); ld_proj8(PROJ, slab, row0 + i - 2, 2 * DA + c0, xa);
#pragma unroll
            for (int e = 0; e < 8; ++e) g[i][e] = gc[e] * xa[e]; }
        else if (SAMP) loadf8(p.in[I_SCONV] + ((size_t)b * 2 + (2 + tt)) * DA + c0, g[i]);
        else {
#pragma unroll
            for (int e = 0; e < 8; ++e) g[i][e] = 0.f; }
    }
#pragma unroll
    for (int i = 0; i < R; ++i) ld_proj8(PROJ, slab, row0 + i, c0, gb[i]);
#pragma unroll
    for (int i = 0; i < R; ++i) {
        float a[8];
#pragma unroll
        for (int e = 0; e < 8; ++e) a[e] = (g[i][e] * w[0][e] + g[i + 1][e] * w[1][e] + g[i + 2][e] * w[2][e]) * gb[i][e];
        store8(CAT + (size_t)(row0 + i) * DM + c0, a);
        const int t = t0 + i;
        if (!SAMP) { if (t >= TP - 2) storef8(out + O_CA_P + ((size_t)b * 2 + (t - (TP - 2))) * DA + c0, g[i + 2]); }
        else { if (t >= 2) storef8(out + O_CA_S + ((size_t)b * 2 + (t - 2)) * DA + c0, g[i + 2]); }
    }
}
template <int R, int W, bool SAMP> __device__ __forceinline__ void pool_task(const Params& p, int row0, int b, int t0, int c0) {
    const bf16_t* PROJ = (const bf16_t*)(p.ws + WS_PROJ); bf16_t* POOLED = (bf16_t*)(p.ws + WS_POOLED); const float* slab = (const float*)(p.ws + WS_SLAB);
    const float* spool = p.in[I_SPOOL]; float* out = p.out;
    float z[R + W - 1][8];
#pragma unroll
    for (int i = 0; i < R + W - 1; ++i) {
        const int tt = t0 + i - (W - 1);
        if (tt >= 0) ld_proj8(PROJ, slab, row0 + i - (W - 1), 3 * DA + c0, z[i]);
        else if (SAMP) loadf8(spool + ((size_t)b * 15 + (15 + tt)) * DB + c0, z[i]);
        else {
#pragma unroll
            for (int e = 0; e < 8; ++e) z[i][e] = 0.f; }
    }
#pragma unroll
    for (int i = 0; i < R; ++i) {
        float s[8];
#pragma unroll
        for (int e = 0; e < 8; ++e) s[e] = z[i][e];
#pragma unroll
        for (int j = 1; j < W; ++j)
#pragma unroll
            for (int e = 0; e < 8; ++e) s[e] += z[i + j][e];
        const int t = t0 + i; const float cnt = SAMP ? (float)W : (float)((t + 1) < W ? (t + 1) : W);
#pragma unroll
        for (int e = 0; e < 8; ++e) s[e] = s[e] / cnt - z[i + W - 1][e];
        store8(POOLED + (size_t)(row0 + i) * DB + c0, s);
        if (!SAMP) { if (t >= TP - 15) storef8(out + O_PL_P + ((size_t)b * 15 + (t - (TP - 15))) * DB + c0, z[i + W - 1]); }
        else storef8(out + O_PL_S + ((size_t)b * 15 + 11 + t) * DB + c0, z[i + W - 1]);
    }
    if (SAMP) { float v[8]; for (int k = 0; k < 11; ++k) { loadf8(spool + ((size_t)b * 15 + k + 4) * DB + c0, v); storef8(out + O_PL_S + ((size_t)b * 15 + k) * DB + c0, v); } }
}
template <int R, bool SAMP> __device__ __forceinline__ void pool_task_g(const Params& p, int row0, int b, int t0, int c0) {
    const int gi = c0 >> 9;
    if (gi == 0) pool_task<R, 2, SAMP>(p, row0, b, t0, c0); else if (gi == 1) pool_task<R, 4, SAMP>(p, row0, b, t0, c0);
    else if (gi == 2) pool_task<R, 8, SAMP>(p, row0, b, t0, c0);
    else { if (R == 8) { pool_task<4, 16, SAMP>(p, row0, b, t0, c0); pool_task<4, 16, SAMP>(p, row0 + 4, b, t0 + 4, c0); } else pool_task<R, 16, SAMP>(p, row0, b, t0, c0); }
}
__device__ __forceinline__ void mixer_phase(const Params& p, int G) {
    bf16_t* CAT = (bf16_t*)(p.ws + WS_CAT); bf16_t* POOLED = (bf16_t*)(p.ws + WS_POOLED);
    constexpr int NT_P = (MP / 8) * 512, NT_S = NBS * 512, NT_Z = (MPAD - MR) * 512;
    for (int it = blockIdx.x * NTHR + threadIdx.x; it < NT_P + NT_S + NT_Z; it += G * NTHR) {
        if (it < NT_P) { const int rg = it >> 9, q = it & 511, row0 = rg * 8, b = row0 >> 11, t0 = row0 & (TP - 1);
            if (q < 256) conv_task<8, false>(p, row0, b, t0, 8 * q); else pool_task_g<8, false>(p, row0, b, t0, 8 * (q - 256)); }
        else if (it < NT_P + NT_S) { const int j = it - NT_P, b = j >> 9, q = j & 511, row0 = MP + b * TS;
            if (q < 256) conv_task<TS, true>(p, row0, b, 0, 8 * q); else pool_task_g<TS, true>(p, row0, b, 0, 8 * (q - 256)); }
        else { const int j = it - NT_P - NT_S, r = MR + (j >> 9), q = j & 511; const u32x4 z = {0u, 0u, 0u, 0u};
            if (q < 256) *(u32x4*)(CAT + (size_t)r * DM + 8 * q) = z; else *(u32x4*)(POOLED + (size_t)r * DB + 8 * (q - 256)) = z; }
    }
}

template <int R, bool SAMP> __device__ __forceinline__ void ffn_task(const Params& p, int layer, const float* rowss, int row0, int b, int t0, int c0) {
    const bf16_t* U = (const bf16_t*)(p.ws + WS_U); bf16_t* ACT = (bf16_t*)(p.ws + WS_ACT); const float* slab = (const float*)(p.ws + WS_SLAB);
    const float* cw = p.in[I_CONVF] + (size_t)layer * 3 * NUP; float* out = p.out;
    float g[R + 2][8], u[R + 2][8], wg[3][8], wu[3][8];
#pragma unroll
    for (int k = 0; k < 3; ++k) { loadf8(cw + (size_t)k * NUP + c0, wg[k]); loadf8(cw + (size_t)k * NUP + DFF + c0, wu[k]); }
#pragma unroll
    for (int i = 0; i < R + 2; ++i) {
        const int tt = t0 + i - 2;
        if (SAMP) {
            if (tt >= 0) { load8(U + (size_t)(row0 + i - 2) * NUP + c0, g[i]); ld_u8(U, slab, rowss, row0 + i - 2, DFF + c0, u[i]); }
            else { const float* sf = p.in[I_SFFN] + (((size_t)layer * NBS + b) * 2 + (2 + tt)) * NUP + c0; loadf8(sf, g[i]); loadf8(sf + DFF, u[i]); }
        } else {
            if (tt >= 0) { load8(U + (size_t)(row0 + i - 2) * NUP + c0, g[i]); load8(U + (size_t)(row0 + i - 2) * NUP + DFF + c0, u[i]); }
            else {
#pragma unroll
                for (int e = 0; e < 8; ++e) { g[i][e] = 0.f; u[i][e] = 0.f; } }
        }
    }
#pragma unroll
    for (int i = 0; i < R; ++i) {
        float a[8];
#pragma unroll
        for (int e = 0; e < 8; ++e) {
            const float cg = g[i][e] * wg[0][e] + g[i + 1][e] * wg[1][e] + g[i + 2][e] * wg[2][e];
            const float cu = u[i][e] * wu[0][e] + u[i + 1][e] * wu[1][e] + u[i + 2][e] * wu[2][e];
            a[e] = cg / (1.0f + __expf(-cg)) * cu; }
        store8(ACT + (size_t)(row0 + i) * DFF + c0, a);
        const int t = t0 + i;
        if (!SAMP) { if (t >= TP - 2) { float* o = out + O_F_P + (((size_t)layer * NBP + b) * 2 + (t - (TP - 2))) * NUP + c0; storef8(o, g[i + 2]); storef8(o + DFF, u[i + 2]); } }
        else { if (t >= 2) { float* o = out + O_F_S + (((size_t)layer * NBS + b) * 2 + (t - 2)) * NUP + c0; storef8(o, g[i + 2]); storef8(o + DFF, u[i + 2]); } }
    }
}
__device__ __forceinline__ void ffnconv_phase(const Params& p, int layer, const float* rowss, int G) {
    constexpr int NCH = DFF / 8;
    constexpr int NT_P = (MP / 8) * NCH, NT_S = NBS * NCH, NT_Z = (MPAD - MR) * NCH;
    bf16_t* ACT = (bf16_t*)(p.ws + WS_ACT);
    for (int it = blockIdx.x * NTHR + threadIdx.x; it < NT_P + NT_S + NT_Z; it += G * NTHR) {
        if (it < NT_P) { const int rg = it / NCH, q = it - rg * NCH, row0 = rg * 8; ffn_task<8, false>(p, layer, rowss, row0, row0 >> 11, row0 & (TP - 1), 8 * q); }
        else if (it < NT_P + NT_S) { const int j = it - NT_P, b = j / NCH, q = j - b * NCH; ffn_task<TS, true>(p, layer, rowss, MP + b * TS, b, 0, 8 * q); }
        else { const int j = it - NT_P - NT_S, r = j / NCH, q = j - r * NCH; *(u32x4*)(ACT + (size_t)(MR + r) * DFF + 8 * q) = (u32x4){0u, 0u, 0u, 0u}; }
    }
}

__device__ __forceinline__ void ffnfix_phase(const Params& p, int layer, int G) {
    constexpr int NCH = DFF / 8;
    constexpr int NT_A = 32 * 4 * NCH, NT_S = NBS * NCH, NT_Z = (MPAD - MR) * NCH;
    bf16_t* ACT = (bf16_t*)(p.ws + WS_ACT); const bf16_t* halo = (const bf16_t*)(p.ws + WS_HALO);
    const float* cw = p.in[I_CONVF] + (size_t)layer * 3 * NUP;
    for (int it = blockIdx.x * NTHR + threadIdx.x; it < NT_A + NT_S + NT_Z; it += G * NTHR) {
        if (it < NT_A) {
            const int pb = it / NCH, q = it - pb * NCH, pm = pb >> 2, blk = pb & 3, c0 = 8 * q;
            const bf16_t* hc = halo + ((size_t)(pm * 4 + blk) * 4) * NUP + c0;
            const bool hasprev = blk > 0 || (pm & 7) != 0;
            const bf16_t* hp = halo + ((size_t)(blk > 0 ? pm * 4 + blk - 1 : (pm - 1) * 4 + 3) * 4 + 2) * NUP + c0;
            float g[4][8], u[4][8], wg[3][8], wu[3][8];
#pragma unroll
            for (int k = 0; k < 3; ++k) { loadf8(cw + (size_t)k * NUP + c0, wg[k]); loadf8(cw + (size_t)k * NUP + DFF + c0, wu[k]); }
            if (hasprev) { load8(hp, g[0]); load8(hp + DFF, u[0]); load8(hp + NUP, g[1]); load8(hp + NUP + DFF, u[1]); }
            else {
#pragma unroll
                for (int e = 0; e < 8; ++e) { g[0][e] = 0.f; u[0][e] = 0.f; g[1][e] = 0.f; u[1][e] = 0.f; } }
            load8(hc, g[2]); load8(hc + DFF, u[2]); load8(hc + NUP, g[3]); load8(hc + NUP + DFF, u[3]);
#pragma unroll
            for (int j = 0; j < 2; ++j) { float a[8];
#pragma unroll
                for (int e = 0; e < 8; ++e) { const float cg = g[j][e] * wg[0][e] + g[j + 1][e] * wg[1][e] + g[j + 2][e] * wg[2][e], cu = u[j][e] * wu[0][e] + u[j + 1][e] * wu[1][e] + u[j + 2][e] * wu[2][e];
                    a[e] = cg / (1.0f + __expf(-cg)) * cu; }
                store8(ACT + (size_t)(pm * 256 + blk * 64 + j) * DFF + c0, a); }
        }
        else if (it < NT_A + NT_S) { const int j = it - NT_A, b = j / NCH, q = j - b * NCH; ffn_task<TS, true>(p, layer, nullptr, MP + b * TS, b, 0, 8 * q); }
        else { const int j = it - NT_A - NT_S, r = j / NCH, q = j - r * NCH; *(u32x4*)(ACT + (size_t)(MR + r) * DFF + 8 * q) = (u32x4){0u, 0u, 0u, 0u}; }
    }
}

__device__ __forceinline__ void cache_copy(const Params& p, int G) {
    float* out = p.out;
    for (int it = blockIdx.x * NTHR + threadIdx.x; it < NBS * (WIN - TS) * 128 * 2; it += G * NTHR) {
        const int kv = it & 1, e = it >> 1, c4 = e & 127, row = (e >> 7) % (WIN - TS), b = (e >> 7) / (WIN - TS);
        const float* src = p.in[kv ? I_CV : I_CK] + ((size_t)b * WIN + row + TS) * 512 + 4 * c4;
        *(f32x4*)(out + (kv ? O_V_S : O_K_S) + ((size_t)b * WIN + row) * 512 + 4 * c4) = *(const f32x4*)src;
    }
}

__device__ __forceinline__ int crow(int r, int hi) { return (r & 3) + 8 * (r >> 2) + 4 * hi; }
struct AttnRegs { u32x4 k[3], v[3]; float sink; };
constexpr int ATT_KST = 72, ATT_VST = 168;
#define ATTN_DECODE(u, samp, b, kh, qb) const bool samp = (u) >= NBP * NKV * (TP / 32); const int b = samp ? (((u) - NBP * NKV * (TP / 32)) >> 3) : ((u) >> 9), kh = samp ? ((u) & 7) : (((u) >> 6) & 7), qb = samp ? 0 : ((u) & 63)
template <bool SAMP> __device__ __forceinline__ void attn_load(const Params& p, int b, int kh, int qb, AttnRegs& R) {
    const int tid = threadIdx.x, lane = tid & 63, wid = __builtin_amdgcn_readfirstlane(tid >> 6), q = lane & 31, hi = lane >> 5;
    const bf16_t* QKV = (const bf16_t*)(p.ws + WS_PROJ);
    const int h = kh * 8 + wid;
    const u32x4 z = {0u, 0u, 0u, 0u};
#pragma unroll
    for (int it = 0; it < 3; ++it) {
        const int c = tid + it * NTHR, rr = c >> 3, ch = c & 7; R.k[it] = z; R.v[it] = z;
        if (c < 160 * 8) {
            if (!SAMP) { const int tk = qb * 32 - 128 + rr;
                if (tk >= 0) { const bf16_t* src = QKV + (size_t)(b * TP + tk) * NQKV + NH * HD + kh * HD + ch * 8; R.k[it] = *(const u32x4*)src; R.v[it] = *(const u32x4*)(src + NKV * HD); } }
            else if (rr < WIN) { float f[8]; const size_t o = (((size_t)b * WIN + rr) * NKV + kh) * HD + ch * 8;
                loadf8(p.in[I_CK] + o, f); R.k[it] = (u32x4){cvtpk(f[0], f[1]), cvtpk(f[2], f[3]), cvtpk(f[4], f[5]), cvtpk(f[6], f[7])};
                loadf8(p.in[I_CV] + o, f); R.v[it] = (u32x4){cvtpk(f[0], f[1]), cvtpk(f[2], f[3]), cvtpk(f[4], f[5]), cvtpk(f[6], f[7])}; }
            else if (rr < WIN + TS) { const bf16_t* src = QKV + (size_t)(MP + b * TS + (rr - WIN)) * NQKV + NH * HD + kh * HD + ch * 8; R.k[it] = *(const u32x4*)src; R.v[it] = *(const u32x4*)(src + NKV * HD); }
        }
    }
    R.sink = p.in[I_SINKS][h];
}
template <bool SAMP> __device__ __forceinline__ void attn_load_q(const Params& p, int b, int kh, int qb, bf16x8 (&qf)[4]) {
    const int tid = threadIdx.x, lane = tid & 63, wid = __builtin_amdgcn_readfirstlane(tid >> 6), q = lane & 31, hi = lane >> 5;
    const bf16_t* QKV = (const bf16_t*)(p.ws + WS_PROJ);
    const int h = kh * 8 + wid;
    const int qrow = SAMP ? MP + b * TS + (q < TS ? q : 0) : b * TP + qb * 32 + q;
#pragma unroll
    for (int d0 = 0; d0 < 4; ++d0) qf[d0] = *(const bf16x8*)(QKV + (size_t)qrow * NQKV + h * HD + 16 * d0 + 8 * hi);
}
__device__ __forceinline__ void attn_stage(LAS bf16_t* Ks, LAS bf16_t* Vt, const AttnRegs& R) {
    const int tid = threadIdx.x;
#pragma unroll
    for (int it = 0; it < 3; ++it) {
        const int c = tid + it * NTHR, rr = c >> 3, ch = c & 7;
        if (c < 160 * 8) {
            *(LAS u32x4*)(Ks + rr * ATT_KST + ch * 8) = R.k[it];
            LAS bf16_t* vd = Vt + (ch * 8) * ATT_VST + rr; const u32x4 v4 = R.v[it];
            vd[0 * ATT_VST] = (bf16_t)(v4.x & 0xffffu); vd[1 * ATT_VST] = (bf16_t)(v4.x >> 16); vd[2 * ATT_VST] = (bf16_t)(v4.y & 0xffffu); vd[3 * ATT_VST] = (bf16_t)(v4.y >> 16);
            vd[4 * ATT_VST] = (bf16_t)(v4.z & 0xffffu); vd[5 * ATT_VST] = (bf16_t)(v4.z >> 16); vd[6 * ATT_VST] = (bf16_t)(v4.w & 0xffffu); vd[7 * ATT_VST] = (bf16_t)(v4.w >> 16);
        }
    }
}
__device__ __forceinline__ void attn_math(const Params& p, LAS bf16_t* Ks, LAS bf16_t* Vt, const bf16x8 (&qf)[4], float sink, bool samp, int b, int kh, int qb) {
    const int tid = threadIdx.x, lane = tid & 63, wid = __builtin_amdgcn_readfirstlane(tid >> 6), q = lane & 31, hi = lane >> 5;
    bf16_t* OB = (bf16_t*)(p.ws + WS_CAT);
    constexpr float C2 = 0.125f * 1.4426950408889634f, L2E = 1.4426950408889634f;
    const int h = kh * 8 + wid;
    const int qrow = samp ? MP + b * TS + (q < TS ? q : 0) : b * TP + qb * 32 + q;
    f32x16 sc[5];
#pragma unroll
    for (int kb = 0; kb < 5; ++kb) {
#pragma unroll
        for (int i = 0; i < 16; ++i) sc[kb][i] = 0.f;
#pragma unroll
        for (int d0 = 0; d0 < 4; ++d0) { const bf16x8 kf = *(const LAS bf16x8*)(Ks + (kb * 32 + q) * ATT_KST + 16 * d0 + 8 * hi);
            sc[kb] = __builtin_amdgcn_mfma_f32_32x32x16_bf16(kf, qf[d0], sc[kb], 0, 0, 0); }
    }
    const int qp = samp ? PAST + q : qb * 32 + q, kbase = samp ? PAST - WIN : qb * 32 - WIN;
    const float sink2 = sink * L2E;
    float mx = sink2;
#pragma unroll
    for (int kb = 0; kb < 5; ++kb)
#pragma unroll
        for (int r = 0; r < 16; ++r) { const int kp = kbase + kb * 32 + crow(r, hi); const bool ok = (kp <= qp) && (kp > qp - WIN) && (kp >= 0);
            const float s = ok ? sc[kb][r] * C2 : -INFINITY; sc[kb][r] = s; mx = fmaxf(mx, s); }
    mx = fmaxf(mx, __shfl_xor(mx, 32));
    float sum = 0.f;
#pragma unroll
    for (int kb = 0; kb < 5; ++kb)
#pragma unroll
        for (int r = 0; r < 16; ++r) { const float e = __builtin_amdgcn_exp2f(sc[kb][r] - mx); sc[kb][r] = e; sum += e; }
    sum += __shfl_xor(sum, 32);
    sum += __builtin_amdgcn_exp2f(sink2 - mx);
    const float inv = 1.0f / sum;
    f32x16 o[2];
#pragma unroll
    for (int i = 0; i < 16; ++i) { o[0][i] = 0.f; o[1][i] = 0.f; }
#pragma unroll
    for (int s16 = 0; s16 < 10; ++s16) {
        const int kb = s16 >> 1, rb = 8 * (s16 & 1);
        u32x4 pw; pw.x = cvtpk(sc[kb][rb + 0], sc[kb][rb + 1]); pw.y = cvtpk(sc[kb][rb + 2], sc[kb][rb + 3]); pw.z = cvtpk(sc[kb][rb + 4], sc[kb][rb + 5]); pw.w = cvtpk(sc[kb][rb + 6], sc[kb][rb + 7]);
        const bf16x8 pf = __builtin_bit_cast(bf16x8, pw);
#pragma unroll
        for (int db = 0; db < 2; ++db) { const LAS bf16_t* vp = Vt + (q + 32 * db) * ATT_VST + 16 * s16 + 4 * hi;
            const u32x2 lo = *(const LAS u32x2*)vp, hh = *(const LAS u32x2*)(vp + 8);
            const bf16x8 vf = __builtin_bit_cast(bf16x8, (u32x4){lo.x, lo.y, hh.x, hh.y});
            o[db] = __builtin_amdgcn_mfma_f32_32x32x16_bf16(vf, pf, o[db], 0, 0, 0); }
    }
    if (!samp || q < TS) {
        bf16_t* orow = OB + (size_t)qrow * DM + h * HD + 4 * hi;
#pragma unroll
        for (int db = 0; db < 2; ++db)
#pragma unroll
            for (int g = 0; g < 4; ++g) *(u32x2*)(orow + 32 * db + 8 * g) = (u32x2){cvtpk(o[db][4 * g] * inv, o[db][4 * g + 1] * inv), cvtpk(o[db][4 * g + 2] * inv, o[db][4 * g + 3] * inv)};
    }
}
__device__ __forceinline__ void attn_phase(const Params& p, LAS unsigned char* lds, int G) {
    LAS bf16_t* Ks = (LAS bf16_t*)lds; LAS bf16_t* Vt = (LAS bf16_t*)(lds + 160 * ATT_KST * 2);
    constexpr int NU_P = NBP * NKV * (TP / 32), NU = NU_P + NBS * NKV;
    AttnRegs R;
    int u = blockIdx.x;
    if (u < NU_P) { ATTN_DECODE(u, s0, b0, kh0, qb0); (void)s0; attn_load<false>(p, b0, kh0, qb0, R); }
    for (; u < NU_P; u += G) {
        ATTN_DECODE(u, samp, b, kh, qb); (void)samp;
        bf16x8 qf[4]; attn_load_q<false>(p, b, kh, qb, qf);
        __syncthreads();
        attn_stage(Ks, Vt, R);
        const float sink = R.sink;
        __syncthreads();
        if (u + G < NU_P) { ATTN_DECODE(u + G, s2, b2, kh2, qb2); (void)s2; attn_load<false>(p, b2, kh2, qb2, R); }
        attn_math(p, Ks, Vt, qf, sink, false, b, kh, qb);
    }
    for (; u < NU; u += G) {
        ATTN_DECODE(u, samp, b, kh, qb); (void)samp;
        attn_load<true>(p, b, kh, qb, R);
        bf16x8 qf[4]; attn_load_q<true>(p, b, kh, qb, qf);
        __syncthreads();
        attn_stage(Ks, Vt, R);
        __syncthreads();
        attn_math(p, Ks, Vt, qf, R.sink, true, b, kh, qb);
    }
}

__device__ __forceinline__ void fold_sample(const Params& p, unsigned* cnt, const float* gain, float* rowss, LAS unsigned char* lds, int G) {
    const int tid = threadIdx.x, lane = tid & 63, wave = tid >> 6;
    if (tid == 0) { unsigned sp = 0; while (__hip_atomic_load(cnt, __ATOMIC_RELAXED, __HIP_MEMORY_SCOPE_AGENT) < 256u) { __builtin_amdgcn_s_sleep(2); if (++sp > (1u << 22)) break; }
        __builtin_amdgcn_fence(__ATOMIC_ACQUIRE, "agent"); asm volatile("s_waitcnt vmcnt(0)" ::: "memory"); }
    __syncthreads();
    float* X = (float*)(p.ws + WS_X); bf16_t* H = (bf16_t*)(p.ws + WS_H); const float* slab = (const float*)(p.ws + WS_SLAB);
    LAS float* red = (LAS float*)lds;
    for (int hr = blockIdx.x; hr < 2 * MS; hr += G) {
        const int srow = hr >> 1, col = (hr & 1) * 2048 + tid * 4;
        float* xq = X + (size_t)(MP + srow) * DM + col;
        f32x4 v = *(const f32x4*)xq;
        const bf16_t* sp = (const bf16_t*)slab + (size_t)srow * DM + col;
#pragma unroll
        for (int q = 0; q < S_RES; ++q) { const u32x2 w = *(const u32x2*)(sp + (size_t)q * 128 * DM); v += (f32x4){bflo(w.x), bfhi(w.x), bflo(w.y), bfhi(w.y)}; }
        *(f32x4*)xq = v;
        if (gain) {
        const f32x4 h = v * *(const f32x4*)(gain + col);
        *(u32x2*)(H + (size_t)(MP + srow) * DM + col) = (u32x2){cvtpk(h.x, h.y), cvtpk(h.z, h.w)};
        const float ss = wave_sum((v.x * v.x + v.y * v.y) + (v.z * v.z + v.w * v.w));
        if (lane == 0) red[wave] = ss;
        __syncthreads();
        if (tid == 0) unsafeAtomicAdd(rowss + MP + srow, ((red[0] + red[1]) + (red[2] + red[3])) + ((red[4] + red[5]) + (red[6] + red[7])));
        __syncthreads(); }
    }
}

__device__ __forceinline__ void fold_bf16(const Params& p, unsigned* cnt, unsigned need, int parts, int ncols, bf16_t* dst, int ldd, int col0, const float* rowss, int G, int gu_pn0 = -1) {
    const int tid = threadIdx.x;
    if (tid == 0) { unsigned sp = 0; while (__hip_atomic_load(cnt, __ATOMIC_RELAXED, __HIP_MEMORY_SCOPE_AGENT) < need) { __builtin_amdgcn_s_sleep(2); if (++sp > (1u << 22)) break; }
        __builtin_amdgcn_fence(__ATOMIC_ACQUIRE, "agent"); asm volatile("s_waitcnt vmcnt(0)" ::: "memory"); }
    __syncthreads();
    const float* slab = (const float*)(p.ws + WS_SLAB);
    const int cpr = ncols / 8;
    for (int ch = blockIdx.x * NTHR + tid; ch < MS * cpr; ch += G * NTHR) {
        const int srow = ch / cpr, c = (ch - srow * cpr) * 8;
        const bf16_t* sp = (const bf16_t*)slab + (size_t)srow * ncols + c;
        f32x4 a = {0.f, 0.f, 0.f, 0.f}, b = {0.f, 0.f, 0.f, 0.f};
        for (int q = 0; q < parts; ++q) { const u32x4 w = *(const u32x4*)sp; a += (f32x4){bflo(w.x), bfhi(w.x), bflo(w.y), bfhi(w.y)}; b += (f32x4){bflo(w.z), bfhi(w.z), bflo(w.w), bfhi(w.w)}; sp += (size_t)128 * ncols; }
        const float rs = rowss ? 1.0f / sqrtf(rowss[MP + srow] * (1.0f / DM) + EPS) : 1.0f;
        a *= rs; b *= rs;
        const int dcol = gu_pn0 < 0 ? col0 + c : ((c >> 7) & 1) * DFF + (gu_pn0 + (c >> 8)) * 128 + (c & 127);
        *(u32x4*)(dst + (size_t)(MP + srow) * ldd + dcol) = (u32x4){cvtpk(a.x, a.y), cvtpk(a.z, a.w), cvtpk(b.x, b.y), cvtpk(b.z, b.w)};
    }
}

constexpr int NPHASE = 19;
__global__ void __launch_bounds__(NTHR, 2) trunk_fwd(Params p) {
    extern __shared__ __attribute__((aligned(16))) unsigned char lds_raw[];
    LAS unsigned char* lds = (LAS unsigned char*)lds_raw;
    volatile LAS unsigned* MISC = (volatile LAS unsigned*)(lds + MISC_OFF);
    const int tid = threadIdx.x, G = gridDim.x;
    unsigned char* ws = p.ws;
    for (int u = tid; u < (LDS_BYTES - LDSCTL_OFF) / 4; u += NTHR) ((LAS unsigned*)(lds + LDSCTL_OFF))[u] = 0u;
    __syncthreads();
#if MK_SPLIT
#define GRID_BAR() do { } while (0)
#else
    XcdBarrier bar = xcd_barrier_post((unsigned*)(ws + WS_CTL) + CW_BAR, MISC + 8);
#define GRID_BAR() do { if (BG_CONV) xcd_barrier_bg(bar, p, lds); else xcd_barrier(bar); } while (0)
#endif
    const int lo = p.ph_lo, hi = p.ph_hi;
#define IN(k) (lo <= (k) && (k) < hi)
#define BG_DL(k) ((k) == 4 ? BQ_UP0 : (k) == 7 ? BQ_DN0 : (k) == 8 ? BQ_QKV : (k) == 12 ? BQ_O : (k) == 13 ? BQ_UP1 : (k) == 16 ? BQ_DN1 : 0)
#define SEAM(k) do { if ((k) + 1 < hi) { if (BG_CONV != 0 && BG_DL(k) != 0) bg_drain(p, lds, MISC + 8, BG_DL(k)); GRID_BAR(); } } while (0)
    const bf16_t* Hb = (const bf16_t*)(ws + WS_H);
    float* X = (float*)(ws + WS_X);
    float* slab = (float*)(ws + WS_SLAB);

    const float* IG = (const float*)(ws + WS_IGAIN);
    float* RS = (float*)(ws + WS_ROWSS);
    unsigned* FC = (unsigned*)(ws + WS_CTL) + CW_FOLD;
    bf16_t* Hw = (bf16_t*)(ws + WS_H);

    if (IN(0)) { REP(0) { prologue_phase(p, lds, G); cache_copy(p, G); norm_phase<0>(p, p.in[I_NMIX], G); } SEAM(0); }
    if (IN(1)) {
        pg8::Gemm g{Hb, (const bf16_t*)(ws + WS_WIN), DM, DM}; pg8::StaticOrder S; S.init(NIN, DM, DM, DM, 0, S_IN, G, (int)blockIdx.x, 1);
        pg8::EpiBf16 E{(bf16_t*)(ws + WS_PROJ), NIN, 0, nullptr, nullptr, nullptr};
        pg8::gemm_phase(lds, g, S, E, slab, NIN, 0, FC + 192); fold_bf16(p, FC + 192, 256u, S_IN, NIN, (bf16_t*)(ws + WS_PROJ), NIN, 0, nullptr, G); SEAM(1); }
    if (IN(2)) { REP(2) mixer_phase(p, G); SEAM(2); }
    if (IN(3)) {
        pg8::Gemm g{(const bf16_t*)(ws + WS_POOLED), (const bf16_t*)(ws + WS_WPOOL), DB, PGRP}; pg8::PoolOrder S; S.init(G, (int)blockIdx.x);
        pg8::EpiBf16 E{(bf16_t*)(ws + WS_CAT) + DA, DM, PGRP, nullptr, p.in[I_PSCALE], nullptr};
        pg8::gemm_phase(lds, g, S, E, slab, 0, 0); SEAM(3); }
    if (IN(4)) {
        pg8::Gemm g{(const bf16_t*)(ws + WS_CAT), (const bf16_t*)(ws + WS_WOUT), DM, DM}; pg8::StaticOrder S; S.init(DM, DM, DM, DM, 0, S_RES, G, (int)blockIdx.x, 1);
        pg8::EpiResid E{Hw, IG + 3 * DM, RS + 4 * MPAD, Hw, p.in[I_NFFN], RS};
        pg8::gemm_phase(lds, g, S, E, slab, DM, 0, FC); fold_sample(p, FC, p.in[I_NFFN], RS, lds, G); SEAM(4); }
    if (IN(6)) {
        pg8::Gemm g{Hb, (const bf16_t*)(ws + WS_WUP), DM, DM}; pg8::StaticOrder S; S.init(NUP, DM, DM, DM, UP_PNSPLIT, S_UP, G, (int)blockIdx.x, 1, pg8::HALF);
        pg8::EpiUpConv E{(bf16_t*)(ws + WS_U), (bf16_t*)(ws + WS_ACT), (bf16_t*)(ws + WS_HALO), RS, p.in[I_CONVF] + (size_t)0 * 3 * NUP, p.out + O_F_P + (size_t)0 * NBP * 2 * NUP};
        pg8::gemm_phase(lds, g, S, E, slab, NUP - UP_PNSPLIT * 256, UP_PNSPLIT, FC + 256);
        fold_bf16(p, FC + 256, (unsigned)((NUP / 256 - UP_PNSPLIT) * S_UP), S_UP, NUP - UP_PNSPLIT * 256, (bf16_t*)(ws + WS_U), NUP, 0, RS, G, UP_PNSPLIT); SEAM(6); }
    if (IN(7)) { ffnfix_phase(p, 0, G); SEAM(7); }
    if (IN(8)) {
        pg8::Gemm g{(const bf16_t*)(ws + WS_ACT), (const bf16_t*)(ws + WS_WDN), DFF, DFF}; pg8::StaticOrder S; S.init(DM, DFF, DFF, DFF, 0, S_RES, G, (int)blockIdx.x, 1);
        pg8::EpiResid E{Hw, IG, nullptr, Hw, p.in[I_NMIX] + DM, RS + MPAD};
        pg8::gemm_phase(lds, g, S, E, slab, DM, 0, FC + 64); fold_sample(p, FC + 64, p.in[I_NMIX] + DM, RS + MPAD, lds, G); SEAM(8); }
    if (IN(10)) {
        pg8::Gemm g{Hb, (const bf16_t*)(ws + WS_WQKV), DM, DM}; pg8::StaticOrder S; S.init(NQKV, DM, DM, DM, NQKV / 256, 1, G, (int)blockIdx.x);
        pg8::EpiQKV E{(bf16_t*)(ws + WS_PROJ), p.in[I_BQKV], RS + MPAD, (const f32x4*)(ws + WS_ROPE), p.out};
        pg8::gemm_phase(lds, g, S, E, slab, 0, 0); SEAM(10); }
    if (IN(12)) { REP(12) attn_phase(p, lds, G); SEAM(12); }
    if (IN(13)) {
        pg8::Gemm g{(const bf16_t*)(ws + WS_CAT), (const bf16_t*)(ws + WS_WO), DM, DM}; pg8::StaticOrder S; S.init(DM, DM, DM, DM, 0, S_RES, G, (int)blockIdx.x, 1);
        pg8::EpiResid E{Hw, IG + DM, nullptr, Hw, p.in[I_NFFN] + DM, RS + 2 * MPAD};
        pg8::gemm_phase(lds, g, S, E, slab, DM, 0, FC + 128); fold_sample(p, FC + 128, p.in[I_NFFN] + DM, RS + 2 * MPAD, lds, G); SEAM(13); }
    if (IN(15)) {
        pg8::Gemm g{Hb, (const bf16_t*)(ws + WS_WUP) + WUP_STRIDE, DM, DM}; pg8::StaticOrder S; S.init(NUP, DM, DM, DM, UP_PNSPLIT, S_UP, G, (int)blockIdx.x, 1, pg8::HALF);
        pg8::EpiUpConv E{(bf16_t*)(ws + WS_U), (bf16_t*)(ws + WS_ACT), (bf16_t*)(ws + WS_HALO), RS + 2 * MPAD, p.in[I_CONVF] + (size_t)1 * 3 * NUP, p.out + O_F_P + (size_t)1 * NBP * 2 * NUP};
        pg8::gemm_phase(lds, g, S, E, slab, NUP - UP_PNSPLIT * 256, UP_PNSPLIT, FC + 320);
        fold_bf16(p, FC + 320, (unsigned)((NUP / 256 - UP_PNSPLIT) * S_UP), S_UP, NUP - UP_PNSPLIT * 256, (bf16_t*)(ws + WS_U), NUP, 0, RS + 2 * MPAD, G, UP_PNSPLIT); SEAM(15); }
    if (IN(16)) { ffnfix_phase(p, 1, G); SEAM(16); }
    if (IN(17)) {
        pg8::Gemm g{(const bf16_t*)(ws + WS_ACT), (const bf16_t*)(ws + WS_WDN) + WDN_STRIDE, DFF, DFF}; pg8::StaticOrder S; S.init(DM, DFF, DFF, DFF, 0, S_RES, G, (int)blockIdx.x, 1);
        pg8::EpiResid E{Hw, IG + 2 * DM, nullptr, Hw, p.in[I_NFIN], RS + 3 * MPAD};
        pg8::gemm_phase(lds, g, S, E, slab, DM, 0, FC + 384); fold_sample(p, FC + 384, nullptr, nullptr, lds, G); SEAM(17); }
    if (IN(18)) { norm_phase<2>(p, p.in[I_NFIN], G); }
#undef IN
#undef SEAM
#undef GRID_BAR
}

extern "C" void kernel_launch(void* const* d_in, const int* in_sizes, int n_in, void* d_out, int out_size, void* d_ws, size_t ws_size, hipStream_t stream) {
    static int grid = 0;
    if (grid == 0) {
        if (n_in != 22 || (size_t)out_size != O_END || ws_size < WS_END) { fprintf(stderr, "kernel_launch: unexpected shapes: n_in %d out %d (want %zu) ws %zu (need %zu); nothing launched\n", n_in, out_size, (size_t)O_END, ws_size, (size_t)WS_END); grid = -1; return; }
        int dev = 0, cus = 0, per_cu = 0;
        if (hipGetDevice(&dev) != hipSuccess || hipDeviceGetAttribute(&cus, hipDeviceAttributeMultiprocessorCount, dev) != hipSuccess) { grid = -1; return; }
        if (hipFuncSetAttribute((const void*)trunk_fwd, hipFuncAttributeMaxDynamicSharedMemorySize, LDS_BYTES) != hipSuccess) { fprintf(stderr, "kernel_launch: hipFuncSetAttribute failed\n"); grid = -1; return; }
        if (hipOccupancyMaxActiveBlocksPerMultiprocessor(&per_cu, (const void*)trunk_fwd, NTHR, LDS_BYTES) != hipSuccess || per_cu < 1) fprintf(stderr, "kernel_launch: occupancy query reports %d\n", per_cu);
        (void)hipGetLastError();
        grid = cus;
    }
    if (grid < 0) return;
    (void)hipMemsetAsync((char*)d_ws + WS_CTL, 0, CTL_ZERO_BYTES, stream);
    Params a{};
    for (int i = 0; i < 22; ++i) a.in[i] = (const float*)d_in[i];
    a.out = (float*)d_out; a.ws = (unsigned char*)d_ws;
#if MK_SPLIT
    for (int ph = 0; ph < NPHASE; ++ph) { a.ph_lo = ph; a.ph_hi = ph + 1; hipLaunchKernelGGL(trunk_fwd, dim3(grid), dim3(NTHR), LDS_BYTES, stream, a); }
#else
    a.ph_lo = 0; a.ph_hi = NPHASE;
    hipLaunchKernelGGL(trunk_fwd, dim3(grid), dim3(NTHR), LDS_BYTES, stream, a);
#endif
}
```

```cpp
#include <hip/hip_runtime.h>
#include <cstdio>
#include <cstdint>

#ifndef PROBE_DUP_GEMM
#define PROBE_DUP_GEMM 0
#endif
#ifndef PROBE_DUP_MASK
#define PROBE_DUP_MASK 0
#endif
#define REP(k) for (int _r = 0; _r < 1 + ((PROBE_DUP_MASK >> (k)) & 1); ++_r)
#ifndef CONV_IN_P0
#define CONV_IN_P0 1
#endif
#ifndef BG_CONV
#define BG_CONV 1
#endif
#ifndef MK_SPLIT
#define MK_SPLIT 0
#endif

#define GAS __attribute__((address_space(1)))
#define LAS __attribute__((address_space(3)))
typedef unsigned short bf16_t;
typedef short bf16x8 __attribute__((ext_vector_type(8)));
typedef float f32x4 __attribute__((ext_vector_type(4)));
typedef float f32x2 __attribute__((ext_vector_type(2)));
typedef float f32x16 __attribute__((ext_vector_type(16)));
typedef unsigned u32x4 __attribute__((ext_vector_type(4)));
typedef unsigned u32x2 __attribute__((ext_vector_type(2)));
typedef __bf16 bf16x2_t __attribute__((ext_vector_type(2)));

constexpr int DM = 4096;
constexpr int MP = 8192, MS = 128, MR = MP + MS, MPAD = 8448, NPANEL = MPAD / 256;
constexpr int TP = 2048, NBP = 4, NBS = 32, TS = 4, PAST = 16384;
constexpr int DA = 2048, DB = 2048, NIN = 8192, PGRP = 512;
constexpr int DFF = 11008, NUP = 22016;
constexpr int NQKV = 5120, NH = 64, NKV = 8, HD = 64, WIN = 128;
constexpr float EPS = 1e-6f;

constexpr size_t O_Y = 0;
constexpr size_t O_CA_P = (size_t)MR * DM;
constexpr size_t O_CA_S = O_CA_P + 4 * 2 * 2048;
constexpr size_t O_PL_P = O_CA_S + 32 * 2 * 2048;
constexpr size_t O_PL_S = O_PL_P + 4 * 15 * 2048;
constexpr size_t O_K_P = O_PL_S + 32 * 15 * 2048;
constexpr size_t O_K_S = O_K_P + 4 * 128 * 512;
constexpr size_t O_V_P = O_K_S + 32 * 128 * 512;
constexpr size_t O_V_S = O_V_P + 4 * 128 * 512;
constexpr size_t O_F_P = O_V_S + 32 * 128 * 512;
constexpr size_t O_F_S = O_F_P + (size_t)2 * 4 * 2 * NUP;
constexpr size_t O_END = O_F_S + (size_t)2 * 32 * 2 * NUP;

constexpr size_t MiB = 1u << 20;
constexpr size_t al(size_t x) { return (x + MiB - 1) / MiB * MiB; }
constexpr size_t WS_CTL = 0, CTL_ZERO_BYTES = 1 * MiB;
constexpr size_t WS_ROPE = 1 * MiB;
constexpr size_t WS_WIN = 2 * MiB;
constexpr size_t WS_WPOOL = WS_WIN + al((size_t)NIN * DM * 2);
constexpr size_t WS_WOUT = WS_WPOOL + al((size_t)4 * 512 * 512 * 2);
constexpr size_t WS_WQKV = WS_WOUT + al((size_t)DM * DM * 2);
constexpr size_t WS_WO = WS_WQKV + al((size_t)NQKV * DM * 2);
constexpr size_t WS_WUP = WS_WO + al((size_t)DM * DM * 2);
constexpr size_t WUP_STRIDE = (size_t)NUP * DM;
constexpr size_t WS_WDN = WS_WUP + al(2 * WUP_STRIDE * 2);
constexpr size_t WDN_STRIDE = (size_t)DM * DFF;
constexpr size_t WS_X = WS_WDN + al(2 * WDN_STRIDE * 2);
constexpr size_t WS_H = WS_X + al((size_t)MPAD * DM * 4);
constexpr size_t WS_PROJ = WS_H + al((size_t)MPAD * DM * 2);
constexpr size_t WS_CAT = WS_PROJ + al((size_t)MPAD * NIN * 2);
constexpr size_t WS_POOLED = WS_CAT + al((size_t)MPAD * DM * 2);
constexpr size_t WS_U = WS_POOLED + al((size_t)MPAD * DB * 2);
constexpr size_t WS_ACT = WS_U + al((size_t)MPAD * NUP * 2);
constexpr size_t WS_SLAB = WS_ACT + al((size_t)MPAD * DFF * 2);
constexpr size_t WS_HALO = WS_SLAB + 32 * MiB;
constexpr size_t WS_END = WS_HALO + al((size_t)32 * 16 * NUP * 4);
constexpr size_t WS_ROWSS = WS_ROPE + 640 * 1024;
constexpr size_t WS_IGAIN = WS_ROPE + 900 * 1024;
constexpr int CW_FOLD = 8192;
constexpr int CW_BAR = 4096;

constexpr int RING_BYTES = 131072;
constexpr int LDS_BYTES = 147456;
constexpr int WLDS_OFF = 131072;
constexpr int LDSCTL_OFF = LDS_BYTES - 1024, MISC_OFF = LDSCTL_OFF + 320;
constexpr int NWAVES = 8, NTHR = 512;

__device__ __forceinline__ unsigned cvtpk(float lo, float hi) { f32x2 v = {lo, hi}; bf16x2_t b = __builtin_convertvector(v, bf16x2_t); return __builtin_bit_cast(unsigned, b); }
__device__ __forceinline__ float bflo(unsigned w) { return __uint_as_float(w << 16); }
__device__ __forceinline__ float bfhi(unsigned w) { return __uint_as_float(w & 0xffff0000u); }
__device__ __forceinline__ void load8(const bf16_t* p, float (&v)[8]) {
    const u32x4 w = *(const u32x4*)p;
    v[0] = bflo(w.x); v[1] = bfhi(w.x); v[2] = bflo(w.y); v[3] = bfhi(w.y); v[4] = bflo(w.z); v[5] = bfhi(w.z); v[6] = bflo(w.w); v[7] = bfhi(w.w);
}
__device__ __forceinline__ void store8(bf16_t* p, const float (&v)[8]) {
    u32x4 w; w.x = cvtpk(v[0], v[1]); w.y = cvtpk(v[2], v[3]); w.z = cvtpk(v[4], v[5]); w.w = cvtpk(v[6], v[7]);
    *(u32x4*)p = w;
}
__device__ __forceinline__ void loadf8(const float* p, float (&v)[8]) {
    const f32x4 a = *(const f32x4*)p, b = *(const f32x4*)(p + 4);
    v[0] = a.x; v[1] = a.y; v[2] = a.z; v[3] = a.w; v[4] = b.x; v[5] = b.y; v[6] = b.z; v[7] = b.w;
}
__device__ __forceinline__ void storef8(float* p, const float (&v)[8]) {
    *(f32x4*)p = (f32x4){v[0], v[1], v[2], v[3]}; *(f32x4*)(p + 4) = (f32x4){v[4], v[5], v[6], v[7]};
}
__device__ __forceinline__ float wave_sum(float v) {
#pragma unroll
    for (int o = 1; o < 64; o <<= 1) v += __shfl_xor(v, o);
    return v;
}

namespace pg8 {
constexpr int BM = 256, BK = 64, HALF = 128, HTB = HALF * BK * 2, STAGE_BYTES = 8 * HTB, NXCD = 8, WGM = 8;
__host__ __device__ __forceinline__ int lds_byte(int r, int c) { const int st = (r >> 4) * 2 + (c >> 5), rr = r & 15, cc = c & 31, ob = rr * 64 + cc * 2; return st * 1024 + (ob ^ (((ob >> 9) & 1) << 5)); }
__host__ __device__ __forceinline__ void stage_rc(int b, int& R, int& C) { const int st = b / 1024, sb = b % 1024, swz = sb ^ (((sb >> 9) & 1) << 5); R = (st >> 1) * 16 + swz / 64; C = (st & 1) * 32 + (swz % 64) / 2; }
__host__ __device__ __forceinline__ int perm32(int rho) { const int n = rho >> 4, i = rho & 15; return 8 * (i >> 2) + 4 * n + (i & 3); }

struct Unit { int pm, pn, g, nkt, mode, sidx; size_t ao, bo; };
struct Gemm { const bf16_t* A; const bf16_t* Bt; int lda, ldb; };

struct StaticOrder {
    int nN, nwgP, nDP, ntot, G, c, npair, pnsplit, s, sfirst; size_t tA, tB;
    __device__ void init(int N, int K, int lda, int ldb, int pnsplit_, int s_, int G_, int c_, int sfirst_ = 0, int brows = BM) { sfirst = sfirst_;   nN = N / BM; nwgP = 32 * nN; pnsplit = pnsplit_; s = s_; nDP = nwgP + pnsplit; ntot = nDP + (nN - pnsplit) * s; G = G_; c = c_; npair = K / (2 * BK);
        tA = (size_t)BM * lda * 2; tB = (size_t)brows * ldb * 2; }
    __device__ bool next(int i, Unit& u) const {
        int L = i * G + c;
        if (sfirst) { const int nsub = ntot - nDP; if (c < nsub) { if (i == 0) L = nDP + c; else { L = (i - 1) * G + c; if (L >= nDP) return false; } } else if (L >= nDP) return false; }
        if (L >= ntot) return false;
        u.g = 0; u.mode = 0; u.sidx = 0; u.nkt = 2 * npair;
        if (L < nwgP) {
            int wgid = L; { const int q = nwgP / NXCD, xcd = wgid % NXCD, off = wgid / NXCD; wgid = xcd * q + off; }
            const int nig = WGM * nN, gid = wgid / nig, fm = gid * WGM;
            u.pm = fm + ((wgid % nig) % WGM); u.pn = (wgid % nig) / WGM; u.ao = (size_t)u.pm * tA; u.bo = (size_t)u.pn * tB;
        } else if (L < nDP) { u.pm = 32; u.pn = L - nwgP; u.ao = 32 * tA; u.bo = (size_t)u.pn * tB; }
        else { const int L2 = L - nDP, t = L2 / s, part = L2 - t * s, p0 = npair * part / s, p1 = npair * (part + 1) / s;
            u.pm = 32; u.pn = pnsplit + t; u.nkt = 2 * (p1 - p0); u.mode = 1; u.sidx = part; u.ao = 32 * tA + (size_t)p0 * 256; u.bo = (size_t)u.pn * tB + (size_t)p0 * 256; }
        return true;
    }
};
struct PoolOrder {
    int G, c;
    __device__ void init(int G_, int c_) { G = G_; c = c_; }
    __device__ bool next(int i, Unit& u) const {
        const int L = i * G + c; if (L >= 4 * NPANEL * 2) return false;
        if (L < 256) { u.g = L >> 6; u.pm = (L & 63) >> 1; u.pn = L & 1; } else { const int L2 = L - 256; u.g = L2 >> 1; u.pm = 32; u.pn = L2 & 1; }
        u.nkt = PGRP / BK; u.mode = 0; u.sidx = 0;
        u.ao = ((size_t)u.pm * BM * DB + (size_t)u.g * PGRP) * 2; u.bo = ((size_t)u.g * PGRP + (size_t)u.pn * BM) * PGRP * 2; return true;
    }
};

struct EpiBf16 {
    static constexpr bool PERM = true; static constexpr int BMODE = 1; static constexpr int AMODE = 0;
    bf16_t* O; int ldc; int gcol; const float* bias; const float* scale; const float* rowss;
    __device__ __forceinline__ void operator()(const f32x4 (&acc)[2][2][4][2], const Unit& u, int wr, int wc, int fr, int fq) const {
        const int row0 = u.pm * BM + wr * 64 + fr; const int col0 = u.g * gcol + u.pn * BM + wc * 32 + 8 * fq;
        f32x4 bv[2][2], sv[2][2];
#pragma unroll
        for (int bj = 0; bj < 2; ++bj)
#pragma unroll
            for (int n = 0; n < 2; ++n) { bv[bj][n] = bias ? *(const f32x4*)(bias + col0 + bj * HALF + 4 * n) : (f32x4){0.f, 0.f, 0.f, 0.f};
                                          sv[bj][n] = scale ? *(const f32x4*)(scale + col0 + bj * HALF + 4 * n) : (f32x4){1.f, 1.f, 1.f, 1.f}; }
#pragma unroll
        for (int ai = 0; ai < 2; ++ai)
#pragma unroll
            for (int m = 0; m < 4; ++m) { bf16_t* rowp = O + (size_t)(row0 + ai * HALF + m * 16) * ldc + col0;
                const float rs = rowss ? 1.0f / sqrtf(rowss[row0 + ai * HALF + m * 16] * (1.0f / DM) + EPS) : 1.0f;
#pragma unroll
                for (int bj = 0; bj < 2; ++bj) { const f32x4 v0 = (acc[ai][bj][m][0] * rs + bv[bj][0]) * sv[bj][0], v1 = (acc[ai][bj][m][1] * rs + bv[bj][1]) * sv[bj][1];
                    u32x4 w; w.x = cvtpk(v0[0], v0[1]); w.y = cvtpk(v0[2], v0[3]); w.z = cvtpk(v1[0], v1[1]); w.w = cvtpk(v1[2], v1[3]);
                    *(u32x4*)(rowp + bj * HALF) = w; } }
    }
};
struct EpiUpU {
    static constexpr bool PERM = true; static constexpr int BMODE = 3; static constexpr int AMODE = 0; static constexpr bool PUBLISH = false;
    bf16_t* O; const float* rowss;
    __device__ __forceinline__ void operator()(const f32x4 (&acc)[2][2][4][2], const Unit& u, int wr, int wc, int fr, int fq) const {
        const int row0 = u.pm * BM + wr * 64 + fr, ch0 = u.pn * HALF + wc * 32 + 8 * fq;
#pragma unroll
        for (int ai = 0; ai < 2; ++ai)
#pragma unroll
            for (int m = 0; m < 4; ++m) { const int row = row0 + ai * HALF + m * 16; bf16_t* rowp = O + (size_t)row * NUP + ch0;
                const float rs = 1.0f / sqrtf(rowss[row] * (1.0f / DM) + EPS);
#pragma unroll
                for (int bj = 0; bj < 2; ++bj) { const f32x4 v0 = acc[ai][bj][m][0] * rs, v1 = acc[ai][bj][m][1] * rs;
                    *(u32x4*)(rowp + bj * DFF) = (u32x4){cvtpk(v0[0], v0[1]), cvtpk(v0[2], v0[3]), cvtpk(v1[0], v1[1]), cvtpk(v1[2], v1[3])}; } }
    }
};
__device__ __forceinline__ f32x4 dpp_shr1(f32x4 v) { f32x4 r;
#pragma unroll
    for (int i = 0; i < 4; ++i) r[i] = __int_as_float(__builtin_amdgcn_update_dpp(0, __float_as_int(v[i]), 0x111, 0xf, 0xf, false)); return r; }
struct EpiUpConv {
    static constexpr bool PERM = true; static constexpr int BMODE = 3; static constexpr int AMODE = 1; static constexpr bool PUBLISH = false;
    bf16_t* U; bf16_t* ACT; bf16_t* halo; const float* rowss; const float* cw; float* fout;
    __device__ __forceinline__ void stage(LAS unsigned char* dst, const Unit& u, int wid, int lane) const {
        if (wid < 3 && u.pm != 32) __builtin_amdgcn_global_load_lds((const unsigned*)(cw + (size_t)wid * NUP + (lane >> 5) * DFF + u.pn * HALF + 4 * (lane & 31)), (LAS unsigned*)(dst + wid * 1024), 16, 0, 0);
    }
    __device__ __forceinline__ void operator()(const f32x4 (&acc)[2][2][4][2], const Unit& u, int wr, int wc, int fr, int fq, const LAS float* wl) const {
        const int rb = u.pm * BM + wr * 64 + 4 * fr, ch0 = u.pn * HALF + wc * 32 + 8 * fq;
        if (u.pm == 32) {
            const f32x4 ss = *(const f32x4*)(rowss + rb);
#pragma unroll
            for (int m = 0; m < 4; ++m) { bf16_t* rowp = U + (size_t)(rb + m) * NUP + ch0;
                const float rs = __builtin_amdgcn_rsqf(ss[m] * (1.0f / DM) + EPS);
#pragma unroll
                for (int bj = 0; bj < 2; ++bj) { const f32x4 v0 = acc[0][bj][m][0] * rs, v1 = acc[0][bj][m][1] * rs;
                    *(u32x4*)(rowp + bj * DFF) = (u32x4){cvtpk(v0[0], v0[1]), cvtpk(v0[2], v0[3]), cvtpk(v1[0], v1[1]), cvtpk(v1[2], v1[3])}; } }
            return;
        }
        const bool f0 = fr == 0, f15 = fr == 15;
        const f32x4 ssq[2] = {*(const f32x4*)(rowss + rb), *(const f32x4*)(rowss + rb + HALF)};
        asm volatile("s_waitcnt vmcnt(0)" ::: "memory");
        const LAS float* wlc = wl + wc * 32 + 8 * fq;
#pragma unroll
        for (int ai = 0; ai < 2; ++ai) {
            const int blk = ai * 2 + wr;
            const f32x4 ss = ssq[ai];
            f32x4 rs;
#pragma unroll
            for (int m = 0; m < 4; ++m) rs[m] = __builtin_amdgcn_rsqf(ss[m] * (1.0f / DM) + EPS);
#pragma unroll
            for (int n = 0; n < 2; ++n) {
                bf16_t* hb = halo + ((size_t)(u.pm * 4 + blk) * 4) * NUP + ch0 + 4 * n;
                f32x4 cg[4];
#pragma unroll
                for (int bj = 0; bj < 2; ++bj) {
                    f32x4 w[3];
#pragma unroll
                    for (int k = 0; k < 3; ++k) w[k] = *(const LAS f32x4*)(wlc + k * 256 + bj * 128 + 4 * n);
                    f32x4 x[4];
#pragma unroll
                    for (int m = 0; m < 4; ++m) x[m] = acc[ai][bj][m][n] * rs[m];
                    if (f0) { *(u32x2*)(hb + bj * DFF) = (u32x2){cvtpk(x[0][0], x[0][1]), cvtpk(x[0][2], x[0][3])}; *(u32x2*)(hb + (size_t)NUP + bj * DFF) = (u32x2){cvtpk(x[1][0], x[1][1]), cvtpk(x[1][2], x[1][3])}; }
                    if (f15) { *(u32x2*)(hb + (size_t)2 * NUP + bj * DFF) = (u32x2){cvtpk(x[2][0], x[2][1]), cvtpk(x[2][2], x[2][3])}; *(u32x2*)(hb + (size_t)3 * NUP + bj * DFF) = (u32x2){cvtpk(x[3][0], x[3][1]), cvtpk(x[3][2], x[3][3])};
                        if ((u.pm & 7) == 7 && blk == 3) { float* fo = fout + ((size_t)(u.pm >> 3) * 2) * NUP + bj * DFF + ch0 + 4 * n; *(f32x4*)fo = x[2]; *(f32x4*)(fo + NUP) = x[3]; } }
                    const f32x4 s2 = dpp_shr1(x[2]), s3 = dpp_shr1(x[3]);
                    if (bj == 0) {
                        cg[0] = s2 * w[0] + s3 * w[1] + x[0] * w[2];
                        cg[1] = s3 * w[0] + x[0] * w[1] + x[1] * w[2];
                        cg[2] = x[0] * w[0] + x[1] * w[1] + x[2] * w[2];
                        cg[3] = x[1] * w[0] + x[2] * w[1] + x[3] * w[2];
                        asm volatile("" ::: "memory");
                    } else {
#pragma unroll
                        for (int m = 0; m < 4; ++m) {
                            const f32x4 cu = (m == 0 ? s2 : m == 1 ? s3 : x[m - 2]) * w[0] + (m == 0 ? s3 : x[m > 0 ? m - 1 : 0]) * w[1] + x[m] * w[2];
                            f32x4 a;
#pragma unroll
                            for (int i = 0; i < 4; ++i) a[i] = cg[m][i] * __builtin_amdgcn_rcpf(1.0f + __expf(-cg[m][i])) * cu[i];
                            if (!(m < 2 && f0)) *(u32x2*)(ACT + (size_t)(rb + ai * HALF + m) * DFF + ch0 + 4 * n) = (u32x2){cvtpk(a[0], a[1]), cvtpk(a[2], a[3])};
                            asm volatile("" ::: "memory");
                        }
                    }
                }
                asm volatile("" ::: "memory");
            }
        }
    }
};
struct EpiResid {
    static constexpr bool PERM = true; static constexpr int BMODE = 1; static constexpr int AMODE = 0;
    const bf16_t* Hold; const float* igain; const float* rowf; bf16_t* H; const float* gain; float* rowss;
    __device__ __forceinline__ void operator()(const f32x4 (&acc)[2][2][4][2], const Unit& u, int wr, int wc, int fr, int fq) const {
        const int row0 = u.pm * BM + wr * 64 + fr, col0 = u.pn * BM + wc * 32 + 8 * fq;
        f32x4 gv[2][2], iv[2][2];
#pragma unroll
        for (int bj = 0; bj < 2; ++bj)
#pragma unroll
            for (int n = 0; n < 2; ++n) { gv[bj][n] = *(const f32x4*)(gain + col0 + bj * HALF + 4 * n); iv[bj][n] = *(const f32x4*)(igain + col0 + bj * HALF + 4 * n); }
        float rf[8];
#pragma unroll
        for (int g = 0; g < 8; ++g) rf[g] = rowf ? sqrtf(rowf[row0 + (g >> 2) * HALF + (g & 3) * 16] * (1.0f / DM) + EPS) : 1.0f;
#pragma unroll
        for (int ai = 0; ai < 2; ++ai)
#pragma unroll
            for (int m = 0; m < 4; ++m) { const int row = row0 + ai * HALF + m * 16;
                const size_t ro = (size_t)row * DM + col0;
                float ss = 0.f;
#pragma unroll
                for (int bj = 0; bj < 2; ++bj) {
                    const u32x4 w = *(const u32x4*)(Hold + ro + bj * HALF);
                    const f32x4 b0 = (f32x4){bflo(w.x), bfhi(w.x), bflo(w.y), bfhi(w.y)} * (iv[bj][0] * rf[ai * 4 + m]), b1 = (f32x4){bflo(w.z), bfhi(w.z), bflo(w.w), bfhi(w.w)} * (iv[bj][1] * rf[ai * 4 + m]);
                    const f32x4 v0 = b0 + acc[ai][bj][m][0], v1 = b1 + acc[ai][bj][m][1];
                    ss += (v0.x * v0.x + v0.y * v0.y) + (v0.z * v0.z + v0.w * v0.w) + (v1.x * v1.x + v1.y * v1.y) + (v1.z * v1.z + v1.w * v1.w);
                    const f32x4 h0 = v0 * gv[bj][0], h1 = v1 * gv[bj][1];
                    *(u32x4*)(H + ro + bj * HALF) = (u32x4){cvtpk(h0.x, h0.y), cvtpk(h0.z, h0.w), cvtpk(h1.x, h1.y), cvtpk(h1.z, h1.w)};
                }
                ss += __shfl_xor(ss, 16); ss += __shfl_xor(ss, 32); if (fq == 0) unsafeAtomicAdd(rowss + row, ss);
            }
    }
};

struct EpiQKV {
    static constexpr bool PERM = true; static constexpr int BMODE = 2; static constexpr int AMODE = 0;
    bf16_t* O; const float* bias; const float* rowss; const f32x4* rope; float* out;
    __device__ __forceinline__ void operator()(const f32x4 (&acc)[2][2][4][2], const Unit& u, int wr, int wc, int fr, int fq) const {
        const int hh = u.pn * 4 + wc, d0 = 8 * fq, colb = hh * HD + d0, row0 = u.pm * BM + wr * 64 + fr;
        f32x4 bv[2][2];
#pragma unroll
        for (int bj = 0; bj < 2; ++bj)
#pragma unroll
            for (int n = 0; n < 2; ++n) bv[bj][n] = *(const f32x4*)(bias + colb + 32 * bj + 4 * n);
#pragma unroll
        for (int ai = 0; ai < 2; ++ai)
#pragma unroll
            for (int m = 0; m < 4; ++m) { const int row = row0 + ai * HALF + m * 16;
                const float rs = 1.0f / sqrtf(rowss[row] * (1.0f / DM) + EPS);
                const bool samp = row >= MP; const int t = samp ? ((row - MP) & (TS - 1)) : (row & (TP - 1)), b = samp ? ((row - MP) >> 2) : (row >> 11);
                f32x4 x[2][2];
#pragma unroll
                for (int bj = 0; bj < 2; ++bj)
#pragma unroll
                    for (int n = 0; n < 2; ++n) x[bj][n] = acc[ai][bj][m][n] * rs + bv[bj][n];
                if (hh < NH + NKV) {
                    const f32x4* cs = rope + ((size_t)((row < MR) ? (samp ? TP + t : t) : 0) * 32 + d0) / 2;
#pragma unroll
                    for (int n = 0; n < 2; ++n) { const f32x4 c01 = cs[2 * n], c23 = cs[2 * n + 1]; const f32x4 a = x[0][n], bb = x[1][n];
                        x[0][n] = (f32x4){a.x * c01.x - bb.x * c01.y, a.y * c01.z - bb.y * c01.w, a.z * c23.x - bb.z * c23.y, a.w * c23.z - bb.w * c23.w};
                        x[1][n] = (f32x4){bb.x * c01.x + a.x * c01.y, bb.y * c01.z + a.y * c01.w, bb.z * c23.x + a.z * c23.y, bb.w * c23.z + a.w * c23.w}; }
                }
                bf16_t* op = O + (size_t)row * NQKV + colb;
#pragma unroll
                for (int bj = 0; bj < 2; ++bj) *(u32x4*)(op + 32 * bj) = (u32x4){cvtpk(x[bj][0].x, x[bj][0].y), cvtpk(x[bj][0].z, x[bj][0].w), cvtpk(x[bj][1].x, x[bj][1].y), cvtpk(x[bj][1].z, x[bj][1].w)};
                if (hh >= NH && row < MR) {
                    const int kvh = (hh - NH) & 7; const bool isv = hh >= NH + NKV; float* o = nullptr;
                    if (!samp) { if (t >= TP - WIN) o = out + (isv ? O_V_P : O_K_P) + (((size_t)b * WIN + (t - (TP - WIN))) * NKV + kvh) * HD + d0; }
                    else o = out + (isv ? O_V_S : O_K_S) + (((size_t)b * WIN + (WIN - TS + t)) * NKV + kvh) * HD + d0;
                    if (o) { *(f32x4*)o = x[0][0]; *(f32x4*)(o + 4) = x[0][1]; *(f32x4*)(o + 32) = x[1][0]; *(f32x4*)(o + 36) = x[1][1]; }
                }
            }
    }
};

template <class Epi, class Sched>
__device__ __forceinline__ void gemm_phase(LAS unsigned char* lds, const Gemm g, const Sched& S, const Epi& E, float* slab, int slabN, int slabPn0, unsigned* pubcnt = nullptr, int ibeg = 0, int iend = 1 << 30) {
    const int tid = threadIdx.x, wid = __builtin_amdgcn_readfirstlane(tid >> 6), lane = tid & 63, wr = wid >> 2, wc = wid & 3, fr = lane & 15, fq = lane >> 4;
    unsigned voffA[2], voffB[2];
#pragma unroll
    for (int i = 0; i < 2; ++i) { int R, C; stage_rc(tid * 16 + i * 8192, R, C);
        const int Rb = Epi::BMODE == 2 ? (64 * (R >> 5) + perm32(R & 31)) : Epi::BMODE != 0 ? ((R & ~31) + perm32(R & 31)) : R;
        const int Ra = Epi::AMODE != 0 ? ((R & ~63) + 4 * (R & 15) + ((R >> 4) & 3)) : R;
        voffA[i] = (unsigned)(Ra * g.lda + C) * 2u; voffB[i] = (unsigned)(Rb * g.ldb + C) * 2u; }
    const size_t kstep = (size_t)(BK * 2);
    const size_t hstepA = (size_t)HALF * g.lda * 2, hstepB = (size_t)(Epi::BMODE == 3 ? DFF : Epi::BMODE == 2 ? 32 : HALF) * g.ldb * 2;
    const unsigned ldsw = (unsigned)wid * 1024u;
    const int aoff = lds_byte(wr * 64 + fr, fq * 8), boff = lds_byte(wc * 32 + fr, fq * 8);
#define PG8_SA(b, h) (((b) * 2 + (h)) * HTB)
#define PG8_SB(b, h) ((4 + (b) * 2 + (h)) * HTB)
#define PG8_STAGE(bufoff, gbase, voff) do { _Pragma("unroll") for (int _i = 0; _i < 2; ++_i) \
        __builtin_amdgcn_global_load_lds((const unsigned*)((const char*)(gbase) + (voff)[_i]), (LAS unsigned*)(lds + (bufoff) + ldsw + _i * 8192), 16, 0, 0); } while (0)
#define PG8_LDA(dst, b, h) do { _Pragma("unroll") for (int m = 0; m < 4; ++m) _Pragma("unroll") for (int k = 0; k < 2; ++k) dst[m][k] = *(const LAS bf16x8*)(lds + PG8_SA(b, h) + aoff + m * 2048 + k * 1024); } while (0)
#define PG8_LDB(dst, b, h) do { _Pragma("unroll") for (int n = 0; n < 2; ++n) _Pragma("unroll") for (int k = 0; k < 2; ++k) dst[n][k] = *(const LAS bf16x8*)(lds + PG8_SB(b, h) + boff + n * 2048 + k * 1024); } while (0)
#define PG8_MMA(ai, bj, At, Bt) do { __builtin_amdgcn_s_setprio(1); _Pragma("unroll") for (int m = 0; m < 4; ++m) _Pragma("unroll") for (int n = 0; n < 2; ++n) _Pragma("unroll") for (int k = 0; k < 2; ++k) \
        acc[ai][bj][m][n] = __builtin_amdgcn_mfma_f32_16x16x32_bf16(Bt[n][k], At[m][k], acc[ai][bj][m][n], 0, 0, 0); __builtin_amdgcn_s_setprio(0); } while (0)
#define PG8_WAIT_V(n) asm volatile("s_waitcnt vmcnt(" #n ")" ::: "memory")
#define PG8_WAIT_L(n) asm volatile("s_waitcnt lgkmcnt(" #n ")" ::: "memory")
#define PG8_BAR __builtin_amdgcn_s_barrier()
#define PG8_SCHED __builtin_amdgcn_sched_barrier(0)
    Unit cur, nxt; int ui = ibeg; bool relax = false;
    if (ibeg >= iend || !S.next(ibeg, cur)) return;
    f32x4 acc[2][2][4][2];
#pragma unroll
    for (int a = 0; a < 2; ++a)
#pragma unroll
        for (int b = 0; b < 2; ++b)
#pragma unroll
            for (int m = 0; m < 4; ++m)
#pragma unroll
                for (int n = 0; n < 2; ++n) acc[a][b][m][n] = (f32x4){0.f, 0.f, 0.f, 0.f};
    bf16x8 At[4][2], B0[2][2], B1[2][2];
    const char* cA = (const char*)g.A + cur.ao; const char* cB = (const char*)g.Bt + cur.bo;
    PG8_STAGE(PG8_SB(0, 0), cB, voffB); PG8_STAGE(PG8_SB(0, 1), cB + hstepB, voffB); PG8_STAGE(PG8_SA(0, 0), cA, voffA); PG8_STAGE(PG8_SA(0, 1), cA + hstepA, voffA);
    if (wr == 1) PG8_BAR;
    PG8_WAIT_V(2); PG8_BAR;
    PG8_STAGE(PG8_SB(1, 0), cB + kstep, voffB); PG8_STAGE(PG8_SA(1, 0), cA + kstep, voffA); PG8_STAGE(PG8_SB(1, 1), cB + hstepB + kstep, voffB);
    PG8_WAIT_V(6); PG8_BAR;
    for (;;) {
        if constexpr (Epi::AMODE != 0) E.stage(lds + WLDS_OFF + (ui & 1) * 3072, cur, wid, lane);
        const bool has_next = (ui + 1 < iend) && S.next(ui + 1, nxt);
        const char* nA = has_next ? (const char*)g.A + nxt.ao : cA; const char* nB = has_next ? (const char*)g.Bt + nxt.bo : cB;
        const int nt = cur.nkt; const bool full = cur.pm != 32;
#define PG8_ITER(W12) do { \
            const bool last = (t == nt - 2); \
            const char* a1 = cA + (size_t)(t + 1) * kstep; \
            const char* a2 = last ? nA : cA + (size_t)(t + 2) * kstep; const char* b2 = last ? nB : cB + (size_t)(t + 2) * kstep; \
            const char* a3 = a2 + kstep; const char* b3 = b2 + kstep; \
            PG8_LDB(B0, 0, 0); PG8_LDB(B1, 0, 1); PG8_SCHED; PG8_LDA(At, 0, 0); PG8_STAGE(PG8_SA(1, 1), a1 + hstepA, voffA); \
            PG8_WAIT_V(W12); PG8_WAIT_L(0); PG8_BAR; PG8_MMA(0, 0, At, B0); PG8_MMA(0, 1, At, B1); PG8_BAR; PG8_SCHED; \
            PG8_LDA(At, 0, 1); PG8_STAGE(PG8_SB(0, 0), b2, voffB); PG8_STAGE(PG8_SB(0, 1), b2 + hstepB, voffB); PG8_STAGE(PG8_SA(0, 0), a2, voffA); \
            PG8_WAIT_V(W12); PG8_WAIT_L(0); PG8_BAR; if (full) { PG8_MMA(1, 0, At, B0); PG8_MMA(1, 1, At, B1); } PG8_BAR; PG8_SCHED; \
            PG8_LDB(B0, 1, 0); PG8_LDB(B1, 1, 1); PG8_SCHED; PG8_LDA(At, 1, 0); PG8_STAGE(PG8_SA(0, 1), a2 + hstepA, voffA); \
            PG8_WAIT_V(8); PG8_WAIT_L(0); PG8_BAR; PG8_MMA(0, 0, At, B0); PG8_MMA(0, 1, At, B1); PG8_BAR; PG8_SCHED; \
            PG8_LDA(At, 1, 1); PG8_STAGE(PG8_SB(1, 0), b3, voffB); PG8_STAGE(PG8_SB(1, 1), b3 + hstepB, voffB); PG8_STAGE(PG8_SA(1, 0), a3, voffA); \
            PG8_WAIT_V(8); PG8_WAIT_L(0); PG8_BAR; if (full) { PG8_MMA(1, 0, At, B0); PG8_MMA(1, 1, At, B1); } PG8_BAR; PG8_SCHED; } while (0)
        int t = 0;
        if constexpr (Epi::BMODE == 3) { if (relax) { PG8_ITER(63); t = 2; } }
        for (; t < nt; t += 2) PG8_ITER(8);
#undef PG8_ITER
        if (wr == 0) PG8_BAR;
        if (cur.mode) {
            static_assert(Epi::PERM, "slab store assumes the lane's 8 columns are contiguous");
            bf16_t* sp = (bf16_t*)slab + ((size_t)cur.sidx * 128 + wr * 64 + (Epi::AMODE != 0 ? 4 * fr : fr)) * slabN + (cur.pn - slabPn0) * BM + wc * 32 + 8 * fq;
#pragma unroll
            for (int m = 0; m < 4; ++m)
#pragma unroll
                for (int bj = 0; bj < 2; ++bj) { bf16_t* dp = sp + (size_t)(Epi::AMODE != 0 ? m : m * 16) * slabN + bj * HALF;
                    const f32x4 a0 = acc[0][bj][m][0], a1 = acc[0][bj][m][1];
                    const u32x4 pv = {cvtpk(a0.x, a0.y), cvtpk(a0.z, a0.w), cvtpk(a1.x, a1.y), cvtpk(a1.z, a1.w)};
                    if (pubcnt) asm volatile("global_store_dwordx4 %0, %1, off sc1" :: "v"(dp), "v"(pv) : "memory");
                    else *(u32x4*)dp = pv; }
            if (pubcnt) { PG8_WAIT_V(0); PG8_BAR; if (tid == 0) __hip_atomic_fetch_add(pubcnt, 1u, __ATOMIC_RELAXED, __HIP_MEMORY_SCOPE_AGENT); }
        } else { if constexpr (Epi::AMODE != 0) E(acc, cur, wr, wc, fr, fq, (const LAS float*)(lds + WLDS_OFF + (ui & 1) * 3072)); else E(acc, cur, wr, wc, fr, fq); }
        relax = !cur.mode && cur.pm != 32;
        if (!has_next) break;
#pragma unroll
        for (int a = 0; a < 2; ++a)
#pragma unroll
            for (int b = 0; b < 2; ++b)
#pragma unroll
                for (int m = 0; m < 4; ++m)
#pragma unroll
                    for (int n = 0; n < 2; ++n) acc[a][b][m][n] = (f32x4){0.f, 0.f, 0.f, 0.f};
        cur = nxt; cA = nA; cB = nB; ++ui;
        if (wr == 1) PG8_BAR;
    }
    PG8_WAIT_V(0);
    PG8_BAR;
#undef PG8_SA
#undef PG8_SB
#undef PG8_STAGE
#undef PG8_LDA
#undef PG8_LDB
#undef PG8_MMA
#undef PG8_WAIT_V
#undef PG8_WAIT_L
#undef PG8_BAR
#undef PG8_SCHED
}
}

#define XB_TMO      128
#define XB_XCNT(j)  (256  + 64 * (j))
#define XB_XSUB(j)  (1280 + 64 * (j))
#define XB_XGEN(j)  (2304 + 64 * (j))
#define XB_TOP      3328
#define XB_TOPGEN   3392
#define XCD_BAR_WORDS 3456
#define XB_SPIN_CAP (1u << 18)
__device__ __forceinline__ unsigned xb_ld(unsigned* p)              { return __hip_atomic_load(p, __ATOMIC_RELAXED, __HIP_MEMORY_SCOPE_AGENT); }
__device__ __forceinline__ unsigned xb_add(unsigned* p, unsigned v) { return __hip_atomic_fetch_add(p, v, __ATOMIC_RELAXED, __HIP_MEMORY_SCOPE_AGENT); }
__device__ __forceinline__ unsigned xb_xcc_id() { return (unsigned)__builtin_amdgcn_s_getreg((3 << 11) | 20) & 0xFu; }
#define XB_SPIN(cond, bar) do { unsigned _sp = 0; while (cond) { __builtin_amdgcn_s_sleep(1); \
    if ((++_sp & 255u) == 0u) { if (xb_ld(&(bar)[XB_TMO])) break; if (_sp > XB_SPIN_CAP) { atomicAdd(&(bar)[XB_TMO], 1u); break; } } } } while (0)
struct XcdBarrier { unsigned* bar; unsigned x; volatile LAS unsigned* st; };
__device__ __forceinline__ XcdBarrier xcd_barrier_post(unsigned* bar, volatile LAS unsigned* st) {
    XcdBarrier b; b.bar = bar; b.x = xb_xcc_id(); b.st = st;
    if (threadIdx.x == 0) (void)xb_add(&bar[XB_XCNT(b.x)], 1u);
    return b;
}
__device__ __forceinline__ void xcd_barrier_complete(unsigned* bar, unsigned x, unsigned& nloc, unsigned& nx) {
    const unsigned G = gridDim.x * gridDim.y * gridDim.z;
    unsigned sum, cnt, mine, sp = 0u;
    for (;;) {
        sum = 0u; cnt = 0u; mine = 0u;
#pragma unroll
        for (unsigned j = 0; j < 16; ++j) { const unsigned c = xb_ld(&bar[XB_XCNT(j)]); sum += c; cnt += (c > 0u) ? 1u : 0u; mine = (j == x) ? c : mine; }
        if (sum == G) break;
        __builtin_amdgcn_s_sleep(1);
        if ((++sp & 255u) == 0u) { if (xb_ld(&bar[XB_TMO])) break; if (sp > XB_SPIN_CAP) { atomicAdd(&bar[XB_TMO], 1u); break; } }
    }
    nloc = mine > 0u ? mine : 1u; nx = cnt > 0u ? cnt : 1u;
}
__device__ __forceinline__ void xcd_barrier(const XcdBarrier& b) {
    asm volatile("s_waitcnt vmcnt(0)" ::: "memory");
    __syncthreads();
    if (threadIdx.x == 0) {
        unsigned* bar = b.bar;
        __builtin_amdgcn_s_waitcnt(0);
        unsigned nloc = b.st[0], nx = b.st[1];
        if (nloc == 0u) { xcd_barrier_complete(bar, b.x, nloc, nx); b.st[0] = nloc; b.st[1] = nx; }
        const unsigned old = xb_add(&bar[XB_XSUB(b.x)], 1u);
        const unsigned gen = old / nloc;
        if (old + 1u == (gen + 1u) * nloc) {
            __builtin_amdgcn_fence(__ATOMIC_RELEASE, "agent");
            asm volatile("s_waitcnt vmcnt(0)" ::: "memory");
            const unsigned og = xb_add(&bar[XB_TOP], 1u);
            const unsigned tg = og / nx;
            if (og + 1u == (tg + 1u) * nx) xb_add(&bar[XB_TOPGEN], 1u);
            else XB_SPIN(xb_ld(&bar[XB_TOPGEN]) == tg, bar);
            __builtin_amdgcn_fence(__ATOMIC_ACQUIRE, "agent");
            xb_add(&bar[XB_XGEN(b.x)], 1u);
            asm volatile("s_waitcnt vmcnt(0)" ::: "memory");
        } else {
            XB_SPIN(xb_ld(&bar[XB_XGEN(b.x)]) == gen, bar);
            __builtin_amdgcn_fence(__ATOMIC_ACQUIRE, "agent");
            asm volatile("s_waitcnt vmcnt(0)" ::: "memory");
        }
    }
    __syncthreads();
}

struct Params;
__device__ __forceinline__ bool bg_step(const Params& p, LAS unsigned char* lds, volatile LAS unsigned* st);
__device__ __forceinline__ void xcd_barrier_bg(const XcdBarrier& b, const Params& p, LAS unsigned char* lds) {
    volatile LAS unsigned* st = b.st;
    asm volatile("s_waitcnt vmcnt(0)" ::: "memory");
    __syncthreads();
    unsigned* bar = b.bar;
    if (threadIdx.x == 0) {
        __builtin_amdgcn_s_waitcnt(0);
        unsigned nloc = st[0], nx = st[1];
        if (nloc == 0u) { xcd_barrier_complete(bar, b.x, nloc, nx); st[0] = nloc; st[1] = nx; }
        const unsigned old = xb_add(&bar[XB_XSUB(b.x)], 1u);
        const unsigned gen = old / nloc;
        const bool leader = old + 1u == (gen + 1u) * nloc;
        st[2] = leader ? 1u : 0u; st[3] = gen;
        if (leader) {
            __builtin_amdgcn_fence(__ATOMIC_RELEASE, "agent");
            asm volatile("s_waitcnt vmcnt(0)" ::: "memory");
            const unsigned og = xb_add(&bar[XB_TOP], 1u);
            const unsigned tg = og / nx;
            if (og + 1u == (tg + 1u) * nx) xb_add(&bar[XB_TOPGEN], 1u);
            else XB_SPIN(xb_ld(&bar[XB_TOPGEN]) == tg, bar);
            __builtin_amdgcn_fence(__ATOMIC_ACQUIRE, "agent");
            xb_add(&bar[XB_XGEN(b.x)], 1u);
            asm volatile("s_waitcnt vmcnt(0)" ::: "memory");
        }
    }
    __syncthreads();
    if (st[2] == 0u) {
        const unsigned gen = st[3];
        __syncthreads();
        for (;;) {
            if (threadIdx.x == 0) st[4] = (xb_ld(&bar[XB_XGEN(b.x)]) != gen) ? 1u : 0u;
            __syncthreads();
            const bool rel = st[4] != 0u;
            __syncthreads();
            if (rel) break;
            if (!bg_step(p, lds, st)) {
                if (threadIdx.x == 0) XB_SPIN(xb_ld(&bar[XB_XGEN(b.x)]) == gen, bar);
                break; }
        }
        if (threadIdx.x == 0) {
            asm volatile("s_waitcnt vmcnt(0)" ::: "memory");
            __builtin_amdgcn_fence(__ATOMIC_ACQUIRE, "agent");
            asm volatile("s_waitcnt vmcnt(0)" ::: "memory");
        }
    }
    __syncthreads();
}

struct Params { const float* in[22]; float* out; unsigned char* ws; int ph_lo, ph_hi; };
enum { I_XP = 0, I_XS, I_SCONV, I_SPOOL, I_CK, I_CV, I_SFFN, I_NMIX, I_WIN, I_CONVA, I_WPOOL, I_PSCALE, I_WOUT, I_WQKV, I_BQKV, I_SINKS, I_WO, I_NFFN, I_WUP, I_CONVF, I_WDN, I_NFIN };

__device__ __forceinline__ void slab_sum8(const float* slab, int N, int s, int srow, int col, float (&v)[8]) {
    const float* sp = slab + (size_t)srow * N + col;
    f32x4 a = {0.f, 0.f, 0.f, 0.f}, b = {0.f, 0.f, 0.f, 0.f};
#pragma unroll 4
    for (int q = 0; q < s; ++q) { a += *(const f32x4*)sp; b += *(const f32x4*)(sp + 4); sp += (size_t)128 * N; }
    v[0] = a.x; v[1] = a.y; v[2] = a.z; v[3] = a.w; v[4] = b.x; v[5] = b.y; v[6] = b.z; v[7] = b.w;
}
constexpr int S_IN = 8, S_RES = 16, S_UP = 11, UP_PNSPLIT = 64;
__device__ __forceinline__ void ld_proj8(const bf16_t* PROJ, const float*, int row, int col, float (&v)[8]) { load8(PROJ + (size_t)row * NIN + col, v); }
__device__ __forceinline__ void ld_u8(const bf16_t* U, const float*, const float*, int row, int col, float (&v)[8]) { load8(U + (size_t)row * NUP + col, v); }

constexpr int TSCR = 64 * 65 * 4;
__device__ __forceinline__ void p0_transpose_item(const float* W, int K, int N, bf16_t* WT, LAS float* scr, int item, int lane) {
    const int nblk = N / 64, kb = item / nblk, nb = item % nblk, k0 = 64 * kb, n0 = 64 * nb;
    const int lr = lane >> 4, lc = (lane & 15) * 4;
    f32x4 tv[16];
#pragma unroll
    for (int i = 0; i < 16; ++i) tv[i] = __builtin_nontemporal_load((const f32x4*)(W + (size_t)(k0 + 4 * i + lr) * N + n0 + lc));
#pragma unroll
    for (int i = 0; i < 16; ++i) { LAS float* d = scr + (4 * i + lr) * 65 + lc; d[0] = tv[i].x; d[1] = tv[i].y; d[2] = tv[i].z; d[3] = tv[i].w; }
    asm volatile("s_waitcnt lgkmcnt(0)" ::: "memory");
    const int c = lane & 7, nl = lane >> 3;
#pragma unroll
    for (int j = 0; j < 8; ++j) { const int n = nl + 8 * j; const LAS float* s = scr + (8 * c) * 65 + n;
        u32x4 o; o.x = cvtpk(s[0 * 65], s[1 * 65]); o.y = cvtpk(s[2 * 65], s[3 * 65]); o.z = cvtpk(s[4 * 65], s[5 * 65]); o.w = cvtpk(s[6 * 65], s[7 * 65]);
        __builtin_nontemporal_store(o, (u32x4*)(WT + (size_t)(n0 + n) * K + k0 + 8 * c)); }
    asm volatile("s_waitcnt lgkmcnt(0)" ::: "memory");
}
constexpr int CI_IN = (DM / 64) * (NIN / 64), CI_PL = (PGRP / 64) * (PGRP / 64), CI_SQ = (DM / 64) * (DM / 64), CI_QKV = (DM / 64) * (NQKV / 64), CI_UP = (DM / 64) * (NUP / 64), CI_DN = (DFF / 64) * (DM / 64);
constexpr int CJ0 = 0, CJ1 = CI_IN, CJ2 = CJ1 + 4 * CI_PL + CI_SQ + CI_UP, CJ3 = CJ2 + CI_DN, CJ4 = CJ3 + CI_QKV + CI_SQ + CI_UP + CI_DN;
__device__ __forceinline__ void convert_one(const Params& p, LAS float* scr, int it, int lane) {
    unsigned char* ws = p.ws; int r = it;
    if (r < CI_IN) { p0_transpose_item(p.in[I_WIN], DM, NIN, (bf16_t*)(ws + WS_WIN), scr, r, lane); return; } r -= CI_IN;
    if (r < 4 * CI_PL) { const int g = r / CI_PL; p0_transpose_item(p.in[I_WPOOL] + (size_t)g * PGRP * PGRP, PGRP, PGRP, (bf16_t*)(ws + WS_WPOOL) + (size_t)g * PGRP * PGRP, scr, r % CI_PL, lane); return; } r -= 4 * CI_PL;
    if (r < CI_SQ) { p0_transpose_item(p.in[I_WOUT], DM, DM, (bf16_t*)(ws + WS_WOUT), scr, r, lane); return; } r -= CI_SQ;
    if (r < CI_UP) { p0_transpose_item(p.in[I_WUP], DM, NUP, (bf16_t*)(ws + WS_WUP), scr, r, lane); return; } r -= CI_UP;
    if (r < CI_DN) { p0_transpose_item(p.in[I_WDN], DFF, DM, (bf16_t*)(ws + WS_WDN), scr, r, lane); return; } r -= CI_DN;
    if (r < CI_QKV) { p0_transpose_item(p.in[I_WQKV], DM, NQKV, (bf16_t*)(ws + WS_WQKV), scr, r, lane); return; } r -= CI_QKV;
    if (r < CI_SQ) { p0_transpose_item(p.in[I_WO], DM, DM, (bf16_t*)(ws + WS_WO), scr, r, lane); return; } r -= CI_SQ;
    if (r < CI_UP) { p0_transpose_item(p.in[I_WUP] + (size_t)DM * NUP, DM, NUP, (bf16_t*)(ws + WS_WUP) + WUP_STRIDE, scr, r, lane); return; } r -= CI_UP;
    p0_transpose_item(p.in[I_WDN] + (size_t)DFF * DM, DFF, DM, (bf16_t*)(ws + WS_WDN) + WDN_STRIDE, scr, r, lane);
}
__device__ __forceinline__ void convert_items(const Params& p, LAS unsigned char* lds, int G, int a, int b) {
    const int tid = threadIdx.x, lane = tid & 63, wave = __builtin_amdgcn_readfirstlane(tid >> 6);
    LAS float* scr = (LAS float*)(lds + wave * TSCR);
    const int gw = blockIdx.x * NWAVES + wave, NGW = G * NWAVES;
    for (int it = a + gw; it < b; it += NGW) convert_one(p, scr, it, lane);
    asm volatile("s_waitcnt vmcnt(0)" ::: "memory"); __syncthreads();
}
constexpr int BQ0 = CI_IN + 4 * CI_PL + CI_SQ;
constexpr int BQ_UP0 = BQ0 + CI_UP, BQ_DN0 = BQ_UP0 + CI_DN, BQ_QKV = BQ_DN0 + CI_QKV, BQ_O = BQ_QKV + CI_SQ, BQ_UP1 = BQ_O + CI_UP, BQ_DN1 = BQ_UP1 + CI_DN;
static_assert(BQ_DN1 == CJ4, "queue covers every remaining item");
constexpr int CW_BGQ = 12288;
__device__ __forceinline__ bool bg_step(const Params& p, LAS unsigned char* lds, volatile LAS unsigned* st) {
    unsigned* ctr = (unsigned*)(p.ws + WS_CTL) + CW_BGQ;
    if (threadIdx.x == 0) st[12] = __hip_atomic_fetch_add(ctr, 1u, __ATOMIC_RELAXED, __HIP_MEMORY_SCOPE_AGENT);
    __syncthreads();
    const int it0 = BQ0 + 8 * (int)st[12];
    __syncthreads();
    if (it0 >= CJ4) return false;
    const int lane = threadIdx.x & 63, wave = __builtin_amdgcn_readfirstlane(threadIdx.x >> 6);
    if (it0 + wave < CJ4) convert_one(p, (LAS float*)(lds + wave * TSCR), it0 + wave, lane);
    return true;
}
__device__ __forceinline__ void bg_drain(const Params& p, LAS unsigned char* lds, volatile LAS unsigned* st, int upto) {
    unsigned* ctr = (unsigned*)(p.ws + WS_CTL) + CW_BGQ;
    for (;;) {
        if (threadIdx.x == 0) st[13] = __hip_atomic_load(ctr, __ATOMIC_RELAXED, __HIP_MEMORY_SCOPE_AGENT);
        __syncthreads();
        const bool done = BQ0 + 8 * (int)st[13] >= upto;
        __syncthreads();
        if (done || !bg_step(p, lds, st)) break;
    }
}
__device__ __forceinline__ void prologue_phase(const Params& p, LAS unsigned char* lds, int G) {
    const int tid = threadIdx.x;
    unsigned char* ws = p.ws;
    convert_items(p, lds, G, CJ0, BG_CONV ? BQ0 : CJ4);
    for (int i = blockIdx.x * NTHR + tid; i < 4 * MPAD; i += G * NTHR) ((float*)(ws + WS_ROWSS))[i] = 0.f;
    for (int i = blockIdx.x * NTHR + tid; i < 4 * DM; i += G * NTHR) { const int k = i / DM, c = i - k * DM;
        ((float*)(ws + WS_IGAIN))[i] = 1.0f / (k == 0 ? p.in[I_NFFN][c] : k == 1 ? p.in[I_NMIX][DM + c] : k == 2 ? p.in[I_NFFN][DM + c] : p.in[I_NMIX][c]); }
    f32x2* rope = (f32x2*)(ws + WS_ROPE);
    for (int i = blockIdx.x * NTHR + tid; i < (TP + TS) * 32; i += G * NTHR) {
        const int pi = i >> 5, d = i & 31; const int pos = pi < TP ? pi : PAST + (pi - TP);
        const float inv = (float)exp2(-(double)d * (13.287712379549449 / 32.0));
        const float ang = (float)pos * inv;
        const double a = (double)ang, kq = __builtin_rint(a * 0.63661977236758134), rr = a - kq * 1.5707963267948966, r2 = rr * rr;
        const double sn = rr * (1.0 + r2 * (-1.0 / 6 + r2 * (1.0 / 120 + r2 * (-1.0 / 5040 + r2 * (1.0 / 362880 + r2 * (-1.0 / 39916800 + r2 * (1.0 / 6227020800.0)))))));
        const double cs = 1.0 + r2 * (-0.5 + r2 * (1.0 / 24 + r2 * (-1.0 / 720 + r2 * (1.0 / 40320 + r2 * (-1.0 / 3628800 + r2 * (1.0 / 479001600.0 + r2 * (-1.0 / 87178291200.0)))))));
        const int qd = (int)((long long)kq & 3);
        const double c = qd == 0 ? cs : qd == 1 ? -sn : qd == 2 ? -cs : sn, s = qd == 0 ? sn : qd == 1 ? cs : qd == 2 ? -sn : -cs;
        rope[i] = (f32x2){(float)c, (float)s};
    }
}

template <int MODE> __device__ __forceinline__ void norm_phase(const Params& p, const float* gain, int G) {
    const int tid = threadIdx.x, lane = tid & 63, wave = __builtin_amdgcn_readfirstlane(tid >> 6);
    const int gw = blockIdx.x * NWAVES + wave, NGW = G * NWAVES;
    float* X = (float*)(p.ws + WS_X); bf16_t* H = (bf16_t*)(p.ws + WS_H); const float* slab = (const float*)(p.ws + WS_SLAB);
    const int nlist = MP + ((MODE == 2) ? 0 : (MPAD - MR));
    for (int i = gw; i < nlist + MS * 16; i += NGW) {
        int r;
        if (i < MP) r = i; else if (i < nlist) r = MR + (i - MP); else { if ((i - nlist) & 15) continue; r = MP + ((i - nlist) >> 4); }
        if (r >= MR) {
            u32x2* o = (u32x2*)(H + (size_t)r * DM) + lane;
#pragma unroll
            for (int j = 0; j < 16; ++j) o[64 * j] = (u32x2){0u, 0u};
            continue;
        }
        if (MODE == 2 && r < MP) {
            const float rs = 1.0f / sqrtf(((const float*)(p.ws + WS_ROWSS))[3 * MPAD + r] * (1.0f / DM) + EPS);
            const u32x4* hr = (const u32x4*)(H + (size_t)r * DM) + lane; f32x4* o = (f32x4*)(p.out + O_Y + (size_t)r * DM) + 2 * lane;
            u32x4 w[8];
#pragma unroll
            for (int j = 0; j < 8; ++j) w[j] = hr[64 * j];
#pragma unroll
            for (int j = 0; j < 8; ++j) { o[128 * j] = (f32x4){bflo(w[j].x), bfhi(w[j].x), bflo(w[j].y), bfhi(w[j].y)} * rs; o[128 * j + 1] = (f32x4){bflo(w[j].z), bfhi(w[j].z), bflo(w[j].w), bfhi(w[j].w)} * rs; }
            continue;
        }
        const float* src = (MODE == 0) ? (r < MP ? p.in[I_XP] + (size_t)r * DM : p.in[I_XS] + (size_t)(r - MP) * DM) : X + (size_t)r * DM;
        const f32x4* xr = (const f32x4*)src + lane;
        f32x4 v[16]; float ss = 0.f;
#pragma unroll
        for (int j = 0; j < 16; ++j) v[j] = xr[64 * j];
        if (r >= MP) {
            f32x4* xw = (f32x4*)(X + (size_t)r * DM) + lane;
            if (MODE == 1) {
                const f32x4* sp = (const f32x4*)(slab + (size_t)(r - MP) * DM) + lane;
                for (int q = 0; q < S_RES; ++q) {
#pragma unroll
                    for (int j = 0; j < 16; ++j) v[j] += sp[64 * j];
                    sp += (size_t)128 * DM / 4; } }
            if (MODE != 2) {
#pragma unroll
                for (int j = 0; j < 16; ++j) xw[64 * j] = v[j]; }
        }
#pragma unroll
        for (int j = 0; j < 16; ++j) ss += (v[j].x * v[j].x + v[j].y * v[j].y) + (v[j].z * v[j].z + v[j].w * v[j].w);
        const float sst = wave_sum(ss);
        if (MODE == 0 && lane == 0) ((float*)(p.ws + WS_ROWSS))[4 * MPAD + r] = sst;
        const float rs = 1.0f / sqrtf(sst * (1.0f / DM) + EPS);
        const f32x4* gr = (const f32x4*)gain + lane;
        if (MODE == 2) { f32x4* o = (f32x4*)(p.out + O_Y + (size_t)r * DM) + lane;
#pragma unroll
            for (int j = 0; j < 16; ++j) { const f32x4 g4 = gr[64 * j]; o[64 * j] = v[j] * rs * g4; }
        } else { u32x2* o = (u32x2*)(H + (size_t)r * DM) + lane;
#pragma unroll
            for (int j = 0; j < 16; ++j) { const f32x4 g4 = gr[64 * j]; const f32x4 y = v[j] * rs * g4; o[64 * j] = (u32x2){cvtpk(y.x, y.y), cvtpk(y.z, y.w)}; }
        }
    }
}

template <int R, bool SAMP> __device__ __forceinline__ void conv_task(const Params& p, int row0, int b, int t0, int c0) {
    const bf16_t* PROJ = (const bf16_t*)(p.ws + WS_PROJ); bf16_t* CAT = (bf16_t*)(p.ws + WS_CAT); const float* slab = (const float*)(p.ws + WS_SLAB);
    const float* cw = p.in[I_CONVA]; float* out = p.out;
    float g[R + 2][8], gb[R][8], w[3][8];
#pragma unroll
    for (int k = 0; k < 3; ++k) loadf8(cw + (size_t)k * DA + c0, w[k]);
#pragma unroll
    for (int i = 0; i < R + 2; ++i) {
        const int tt = t0 + i - 2;
        if (tt >= 0) { float gc[8], xa[8]; ld_proj8(PROJ, slab, row0 + i - 2, DA + c0, gc); ld_proj8(PROJ, slab, row0 + i - 2, 2 * DA + c0, xa);
#pragma unroll
            for (int e = 0; e < 8; ++e) g[i][e] = gc[e] * xa[e]; }
        else if (SAMP) loadf8(p.in[I_SCONV] + ((size_t)b * 2 + (2 + tt)) * DA + c0, g[i]);
        else {
#pragma unroll
            for (int e = 0; e < 8; ++e) g[i][e] = 0.f; }
    }
#pragma unroll
    for (int i = 0; i < R; ++i) ld_proj8(PROJ, slab, row0 + i, c0, gb[i]);
#pragma unroll
    for (int i = 0; i < R; ++i) {
        float a[8];
#pragma unroll
        for (int e = 0; e < 8; ++e) a[e] = (g[i][e] * w[0][e] + g[i + 1][e] * w[1][e] + g[i + 2][e] * w[2][e]) * gb[i][e];
        store8(CAT + (size_t)(row0 + i) * DM + c0, a);
        const int t = t0 + i;
        if (!SAMP) { if (t >= TP - 2) storef8(out + O_CA_P + ((size_t)b * 2 + (t - (TP - 2))) * DA + c0, g[i + 2]); }
        else { if (t >= 2) storef8(out + O_CA_S + ((size_t)b * 2 + (t - 2)) * DA + c0, g[i + 2]); }
    }
}
template <int R, int W, bool SAMP> __device__ __forceinline__ void pool_task(const Params& p, int row0, int b, int t0, int c0) {
    const bf16_t* PROJ = (const bf16_t*)(p.ws + WS_PROJ); bf16_t* POOLED = (bf16_t*)(p.ws + WS_POOLED); const float* slab = (const float*)(p.ws + WS_SLAB);
    const float* spool = p.in[I_SPOOL]; float* out = p.out;
    float z[R + W - 1][8];
#pragma unroll
    for (int i = 0; i < R + W - 1; ++i) {
        const int tt = t0 + i - (W - 1);
        if (tt >= 0) ld_proj8(PROJ, slab, row0 + i - (W - 1), 3 * DA + c0, z[i]);
        else if (SAMP) loadf8(spool + ((size_t)b * 15 + (15 + tt)) * DB + c0, z[i]);
        else {
#pragma unroll
            for (int e = 0; e < 8; ++e) z[i][e] = 0.f; }
    }
#pragma unroll
    for (int i = 0; i < R; ++i) {
        float s[8];
#pragma unroll
        for (int e = 0; e < 8; ++e) s[e] = z[i][e];
#pragma unroll
        for (int j = 1; j < W; ++j)
#pragma unroll
            for (int e = 0; e < 8; ++e) s[e] += z[i + j][e];
        const int t = t0 + i; const float cnt = SAMP ? (float)W : (float)((t + 1) < W ? (t + 1) : W);
#pragma unroll
        for (int e = 0; e < 8; ++e) s[e] = s[e] / cnt - z[i + W - 1][e];
        store8(POOLED + (size_t)(row0 + i) * DB + c0, s);
        if (!SAMP) { if (t >= TP - 15) storef8(out + O_PL_P + ((size_t)b * 15 + (t - (TP - 15))) * DB + c0, z[i + W - 1]); }
        else storef8(out + O_PL_S + ((size_t)b * 15 + 11 + t) * DB + c0, z[i + W - 1]);
    }
    if (SAMP) { float v[8]; for (int k = 0; k < 11; ++k) { loadf8(spool + ((size_t)b * 15 + k + 4) * DB + c0, v); storef8(out + O_PL_S + ((size_t)b * 15 + k) * DB + c0, v); } }
}
template <int R, bool SAMP> __device__ __forceinline__ void pool_task_g(const Params& p, int row0, int b, int t0, int c0) {
    const int gi = c0 >> 9;
    if (gi == 0) pool_task<R, 2, SAMP>(p, row0, b, t0, c0); else if (gi == 1) pool_task<R, 4, SAMP>(p, row0, b, t0, c0);
    else if (gi == 2) pool_task<R, 8, SAMP>(p, row0, b, t0, c0);
    else { if (R == 8) { pool_task<4, 16, SAMP>(p, row0, b, t0, c0); pool_task<4, 16, SAMP>(p, row0 + 4, b, t0 + 4, c0); } else pool_task<R, 16, SAMP>(p, row0, b, t0, c0); }
}
__device__ __forceinline__ void mixer_phase(const Params& p, int G) {
    bf16_t* CAT = (bf16_t*)(p.ws + WS_CAT); bf16_t* POOLED = (bf16_t*)(p.ws + WS_POOLED);
    constexpr int NT_P = (MP / 8) * 512, NT_S = NBS * 512, NT_Z = (MPAD - MR) * 512;
    for (int it = blockIdx.x * NTHR + threadIdx.x; it < NT_P + NT_S + NT_Z; it += G * NTHR) {
        if (it < NT_P) { const int rg = it >> 9, q = it & 511, row0 = rg * 8, b = row0 >> 11, t0 = row0 & (TP - 1);
            if (q < 256) conv_task<8, false>(p, row0, b, t0, 8 * q); else pool_task_g<8, false>(p, row0, b, t0, 8 * (q - 256)); }
        else if (it < NT_P + NT_S) { const int j = it - NT_P, b = j >> 9, q = j & 511, row0 = MP + b * TS;
            if (q < 256) conv_task<TS, true>(p, row0, b, 0, 8 * q); else pool_task_g<TS, true>(p, row0, b, 0, 8 * (q - 256)); }
        else { const int j = it - NT_P - NT_S, r = MR + (j >> 9), q = j & 511; const u32x4 z = {0u, 0u, 0u, 0u};
            if (q < 256) *(u32x4*)(CAT + (size_t)r * DM + 8 * q) = z; else *(u32x4*)(POOLED + (size_t)r * DB + 8 * (q - 256)) = z; }
    }
}

template <int R, bool SAMP> __device__ __forceinline__ void ffn_task(const Params& p, int layer, const float* rowss, int row0, int b, int t0, int c0) {
    const bf16_t* U = (const bf16_t*)(p.ws + WS_U); bf16_t* ACT = (bf16_t*)(p.ws + WS_ACT); const float* slab = (const float*)(p.ws + WS_SLAB);
    const float* cw = p.in[I_CONVF] + (size_t)layer * 3 * NUP; float* out = p.out;
    float g[R + 2][8], u[R + 2][8], wg[3][8], wu[3][8];
#pragma unroll
    for (int k = 0; k < 3; ++k) { loadf8(cw + (size_t)k * NUP + c0, wg[k]); loadf8(cw + (size_t)k * NUP + DFF + c0, wu[k]); }
#pragma unroll
    for (int i = 0; i < R + 2; ++i) {
        const int tt = t0 + i - 2;
        if (SAMP) {
            if (tt >= 0) { load8(U + (size_t)(row0 + i - 2) * NUP + c0, g[i]); ld_u8(U, slab, rowss, row0 + i - 2, DFF + c0, u[i]); }
            else { const float* sf = p.in[I_SFFN] + (((size_t)layer * NBS + b) * 2 + (2 + tt)) * NUP + c0; loadf8(sf, g[i]); loadf8(sf + DFF, u[i]); }
        } else {
            if (tt >= 0) { load8(U + (size_t)(row0 + i - 2) * NUP + c0, g[i]); load8(U + (size_t)(row0 + i - 2) * NUP + DFF + c0, u[i]); }
            else {
#pragma unroll
                for (int e = 0; e < 8; ++e) { g[i][e] = 0.f; u[i][e] = 0.f; } }
        }
    }
#pragma unroll
    for (int i = 0; i < R; ++i) {
        float a[8];
#pragma unroll
        for (int e = 0; e < 8; ++e) {
            const float cg = g[i][e] * wg[0][e] + g[i + 1][e] * wg[1][e] + g[i + 2][e] * wg[2][e];
            const float cu = u[i][e] * wu[0][e] + u[i + 1][e] * wu[1][e] + u[i + 2][e] * wu[2][e];
            a[e] = cg / (1.0f + __expf(-cg)) * cu; }
        store8(ACT + (size_t)(row0 + i) * DFF + c0, a);
        const int t = t0 + i;
        if (!SAMP) { if (t >= TP - 2) { float* o = out + O_F_P + (((size_t)layer * NBP + b) * 2 + (t - (TP - 2))) * NUP + c0; storef8(o, g[i + 2]); storef8(o + DFF, u[i + 2]); } }
        else { if (t >= 2) { float* o = out + O_F_S + (((size_t)layer * NBS + b) * 2 + (t - 2)) * NUP + c0; storef8(o, g[i + 2]); storef8(o + DFF, u[i + 2]); } }
    }
}
__device__ __forceinline__ void ffnconv_phase(const Params& p, int layer, const float* rowss, int G) {
    constexpr int NCH = DFF / 8;
    constexpr int NT_P = (MP / 8) * NCH, NT_S = NBS * NCH, NT_Z = (MPAD - MR) * NCH;
    bf16_t* ACT = (bf16_t*)(p.ws + WS_ACT);
    for (int it = blockIdx.x * NTHR + threadIdx.x; it < NT_P + NT_S + NT_Z; it += G * NTHR) {
        if (it < NT_P) { const int rg = it / NCH, q = it - rg * NCH, row0 = rg * 8; ffn_task<8, false>(p, layer, rowss, row0, row0 >> 11, row0 & (TP - 1), 8 * q); }
        else if (it < NT_P + NT_S) { const int j = it - NT_P, b = j / NCH, q = j - b * NCH; ffn_task<TS, true>(p, layer, rowss, MP + b * TS, b, 0, 8 * q); }
        else { const int j = it - NT_P - NT_S, r = j / NCH, q = j - r * NCH; *(u32x4*)(ACT + (size_t)(MR + r) * DFF + 8 * q) = (u32x4){0u, 0u, 0u, 0u}; }
    }
}

__device__ __forceinline__ void ffnfix_phase(const Params& p, int layer, int G) {
    constexpr int NCH = DFF / 8;
    constexpr int NT_A = 32 * 4 * NCH, NT_S = NBS * NCH, NT_Z = (MPAD - MR) * NCH;
    bf16_t* ACT = (bf16_t*)(p.ws + WS_ACT); const bf16_t* halo = (const bf16_t*)(p.ws + WS_HALO);
    const float* cw = p.in[I_CONVF] + (size_t)layer * 3 * NUP;
    for (int it = blockIdx.x * NTHR + threadIdx.x; it < NT_A + NT_S + NT_Z; it += G * NTHR) {
        if (it < NT_A) {
            const int pb = it / NCH, q = it - pb * NCH, pm = pb >> 2, blk = pb & 3, c0 = 8 * q;
            const bf16_t* hc = halo + ((size_t)(pm * 4 + blk) * 4) * NUP + c0;
            const bool hasprev = blk > 0 || (pm & 7) != 0;
            const bf16_t* hp = halo + ((size_t)(blk > 0 ? pm * 4 + blk - 1 : (pm - 1) * 4 + 3) * 4 + 2) * NUP + c0;
            float g[4][8], u[4][8], wg[3][8], wu[3][8];
#pragma unroll
            for (int k = 0; k < 3; ++k) { loadf8(cw + (size_t)k * NUP + c0, wg[k]); loadf8(cw + (size_t)k * NUP + DFF + c0, wu[k]); }
            if (hasprev) { load8(hp, g[0]); load8(hp + DFF, u[0]); load8(hp + NUP, g[1]); load8(hp + NUP + DFF, u[1]); }
            else {
#pragma unroll
                for (int e = 0; e < 8; ++e) { g[0][e] = 0.f; u[0][e] = 0.f; g[1][e] = 0.f; u[1][e] = 0.f; } }
            load8(hc, g[2]); load8(hc + DFF, u[2]); load8(hc + NUP, g[3]); load8(hc + NUP + DFF, u[3]);
#pragma unroll
            for (int j = 0; j < 2; ++j) { float a[8];
#pragma unroll
                for (int e = 0; e < 8; ++e) { const float cg = g[j][e] * wg[0][e] + g[j + 1][e] * wg[1][e] + g[j + 2][e] * wg[2][e], cu = u[j][e] * wu[0][e] + u[j + 1][e] * wu[1][e] + u[j + 2][e] * wu[2][e];
                    a[e] = cg / (1.0f + __expf(-cg)) * cu; }
                store8(ACT + (size_t)(pm * 256 + blk * 64 + j) * DFF + c0, a); }
        }
        else if (it < NT_A + NT_S) { const int j = it - NT_A, b = j / NCH, q = j - b * NCH; ffn_task<TS, true>(p, layer, nullptr, MP + b * TS, b, 0, 8 * q); }
        else { const int j = it - NT_A - NT_S, r = j / NCH, q = j - r * NCH; *(u32x4*)(ACT + (size_t)(MR + r) * DFF + 8 * q) = (u32x4){0u, 0u, 0u, 0u}; }
    }
}

__device__ __forceinline__ void cache_copy(const Params& p, int G) {
    float* out = p.out;
    for (int it = blockIdx.x * NTHR + threadIdx.x; it < NBS * (WIN - TS) * 128 * 2; it += G * NTHR) {
        const int kv = it & 1, e = it >> 1, c4 = e & 127, row = (e >> 7) % (WIN - TS), b = (e >> 7) / (WIN - TS);
        const float* src = p.in[kv ? I_CV : I_CK] + ((size_t)b * WIN + row + TS) * 512 + 4 * c4;
        *(f32x4*)(out + (kv ? O_V_S : O_K_S) + ((size_t)b * WIN + row) * 512 + 4 * c4) = *(const f32x4*)src;
    }
}

__device__ __forceinline__ int crow(int r, int hi) { return (r & 3) + 8 * (r >> 2) + 4 * hi; }
struct AttnRegs { u32x4 k[3], v[3]; float sink; };
constexpr int ATT_KST = 72, ATT_VST = 168;
#define ATTN_DECODE(u, samp, b, kh, qb) const bool samp = (u) >= NBP * NKV * (TP / 32); const int b = samp ? (((u) - NBP * NKV * (TP / 32)) >> 3) : ((u) >> 9), kh = samp ? ((u) & 7) : (((u) >> 6) & 7), qb = samp ? 0 : ((u) & 63)
template <bool SAMP> __device__ __forceinline__ void attn_load(const Params& p, int b, int kh, int qb, AttnRegs& R) {
    const int tid = threadIdx.x, lane = tid & 63, wid = __builtin_amdgcn_readfirstlane(tid >> 6), q = lane & 31, hi = lane >> 5;
    const bf16_t* QKV = (const bf16_t*)(p.ws + WS_PROJ);
    const int h = kh * 8 + wid;
    const u32x4 z = {0u, 0u, 0u, 0u};
#pragma unroll
    for (int it = 0; it < 3; ++it) {
        const int c = tid + it * NTHR, rr = c >> 3, ch = c & 7; R.k[it] = z; R.v[it] = z;
        if (c < 160 * 8) {
            if (!SAMP) { const int tk = qb * 32 - 128 + rr;
                if (tk >= 0) { const bf16_t* src = QKV + (size_t)(b * TP + tk) * NQKV + NH * HD + kh * HD + ch * 8; R.k[it] = *(const u32x4*)src; R.v[it] = *(const u32x4*)(src + NKV * HD); } }
            else if (rr < WIN) { float f[8]; const size_t o = (((size_t)b * WIN + rr) * NKV + kh) * HD + ch * 8;
                loadf8(p.in[I_CK] + o, f); R.k[it] = (u32x4){cvtpk(f[0], f[1]), cvtpk(f[2], f[3]), cvtpk(f[4], f[5]), cvtpk(f[6], f[7])};
                loadf8(p.in[I_CV] + o, f); R.v[it] = (u32x4){cvtpk(f[0], f[1]), cvtpk(f[2], f[3]), cvtpk(f[4], f[5]), cvtpk(f[6], f[7])}; }
            else if (rr < WIN + TS) { const bf16_t* src = QKV + (size_t)(MP + b * TS + (rr - WIN)) * NQKV + NH * HD + kh * HD + ch * 8; R.k[it] = *(const u32x4*)src; R.v[it] = *(const u32x4*)(src + NKV * HD); }
        }
    }
    R.sink = p.in[I_SINKS][h];
}
template <bool SAMP> __device__ __forceinline__ void attn_load_q(const Params& p, int b, int kh, int qb, bf16x8 (&qf)[4]) {
    const int tid = threadIdx.x, lane = tid & 63, wid = __builtin_amdgcn_readfirstlane(tid >> 6), q = lane & 31, hi = lane >> 5;
    const bf16_t* QKV = (const bf16_t*)(p.ws + WS_PROJ);
    const int h = kh * 8 + wid;
    const int qrow = SAMP ? MP + b * TS + (q < TS ? q : 0) : b * TP + qb * 32 + q;
#pragma unroll
    for (int d0 = 0; d0 < 4; ++d0) qf[d0] = *(const bf16x8*)(QKV + (size_t)qrow * NQKV + h * HD + 16 * d0 + 8 * hi);
}
__device__ __forceinline__ void attn_stage(LAS bf16_t* Ks, LAS bf16_t* Vt, const AttnRegs& R) {
    const int tid = threadIdx.x;
#pragma unroll
    for (int it = 0; it < 3; ++it) {
        const int c = tid + it * NTHR, rr = c >> 3, ch = c & 7;
        if (c < 160 * 8) {
            *(LAS u32x4*)(Ks + rr * ATT_KST + ch * 8) = R.k[it];
            LAS bf16_t* vd = Vt + (ch * 8) * ATT_VST + rr; const u32x4 v4 = R.v[it];
            vd[0 * ATT_VST] = (bf16_t)(v4.x & 0xffffu); vd[1 * ATT_VST] = (bf16_t)(v4.x >> 16); vd[2 * ATT_VST] = (bf16_t)(v4.y & 0xffffu); vd[3 * ATT_VST] = (bf16_t)(v4.y >> 16);
            vd[4 * ATT_VST] = (bf16_t)(v4.z & 0xffffu); vd[5 * ATT_VST] = (bf16_t)(v4.z >> 16); vd[6 * ATT_VST] = (bf16_t)(v4.w & 0xffffu); vd[7 * ATT_VST] = (bf16_t)(v4.w >> 16);
        }
    }
}
__device__ __forceinline__ void attn_math(const Params& p, LAS bf16_t* Ks, LAS bf16_t* Vt, const bf16x8 (&qf)[4], float sink, bool samp, int b, int kh, int qb) {
    const int tid = threadIdx.x, lane = tid & 63, wid = __builtin_amdgcn_readfirstlane(tid >> 6), q = lane & 31, hi = lane >> 5;
    bf16_t* OB = (bf16_t*)(p.ws + WS_CAT);
    constexpr float C2 = 0.125f * 1.4426950408889634f, L2E = 1.4426950408889634f;
    const int h = kh * 8 + wid;
    const int qrow = samp ? MP + b * TS + (q < TS ? q : 0) : b * TP + qb * 32 + q;
    f32x16 sc[5];
#pragma unroll
    for (int kb = 0; kb < 5; ++kb) {
#pragma unroll
        for (int i = 0; i < 16; ++i) sc[kb][i] = 0.f;
#pragma unroll
        for (int d0 = 0; d0 < 4; ++d0) { const bf16x8 kf = *(const LAS bf16x8*)(Ks + (kb * 32 + q) * ATT_KST + 16 * d0 + 8 * hi);
            sc[kb] = __builtin_amdgcn_mfma_f32_32x32x16_bf16(kf, qf[d0], sc[kb], 0, 0, 0); }
    }
    const int qp = samp ? PAST + q : qb * 32 + q, kbase = samp ? PAST - WIN : qb * 32 - WIN;
    const float sink2 = sink * L2E;
    float mx = sink2;
#pragma unroll
    for (int kb = 0; kb < 5; ++kb)
#pragma unroll
        for (int r = 0; r < 16; ++r) { const int kp = kbase + kb * 32 + crow(r, hi); const bool ok = (kp <= qp) && (kp > qp - WIN) && (kp >= 0);
            const float s = ok ? sc[kb][r] * C2 : -INFINITY; sc[kb][r] = s; mx = fmaxf(mx, s); }
    mx = fmaxf(mx, __shfl_xor(mx, 32));
    float sum = 0.f;
#pragma unroll
    for (int kb = 0; kb < 5; ++kb)
#pragma unroll
        for (int r = 0; r < 16; ++r) { const float e = __builtin_amdgcn_exp2f(sc[kb][r] - mx); sc[kb][r] = e; sum += e; }
    sum += __shfl_xor(sum, 32);
    sum += __builtin_amdgcn_exp2f(sink2 - mx);
    const float inv = 1.0f / sum;
    f32x16 o[2];
#pragma unroll
    for (int i = 0; i < 16; ++i) { o[0][i] = 0.f; o[1][i] = 0.f; }
#pragma unroll
    for (int s16 = 0; s16 < 10; ++s16) {
        const int kb = s16 >> 1, rb = 8 * (s16 & 1);
        u32x4 pw; pw.x = cvtpk(sc[kb][rb + 0], sc[kb][rb + 1]); pw.y = cvtpk(sc[kb][rb + 2], sc[kb][rb + 3]); pw.z = cvtpk(sc[kb][rb + 4], sc[kb][rb + 5]); pw.w = cvtpk(sc[kb][rb + 6], sc[kb][rb + 7]);
        const bf16x8 pf = __builtin_bit_cast(bf16x8, pw);
#pragma unroll
        for (int db = 0; db < 2; ++db) { const LAS bf16_t* vp = Vt + (q + 32 * db) * ATT_VST + 16 * s16 + 4 * hi;
            const u32x2 lo = *(const LAS u32x2*)vp, hh = *(const LAS u32x2*)(vp + 8);
            const bf16x8 vf = __builtin_bit_cast(bf16x8, (u32x4){lo.x, lo.y, hh.x, hh.y});
            o[db] = __builtin_amdgcn_mfma_f32_32x32x16_bf16(vf, pf, o[db], 0, 0, 0); }
    }
    if (!samp || q < TS) {
        bf16_t* orow = OB + (size_t)qrow * DM + h * HD + 4 * hi;
#pragma unroll
        for (int db = 0; db < 2; ++db)
#pragma unroll
            for (int g = 0; g < 4; ++g) *(u32x2*)(orow + 32 * db + 8 * g) = (u32x2){cvtpk(o[db][4 * g] * inv, o[db][4 * g + 1] * inv), cvtpk(o[db][4 * g + 2] * inv, o[db][4 * g + 3] * inv)};
    }
}
__device__ __forceinline__ void attn_phase(const Params& p, LAS unsigned char* lds, int G) {
    LAS bf16_t* Ks = (LAS bf16_t*)lds; LAS bf16_t* Vt = (LAS bf16_t*)(lds + 160 * ATT_KST * 2);
    constexpr int NU_P = NBP * NKV * (TP / 32), NU = NU_P + NBS * NKV;
    AttnRegs R;
    int u = blockIdx.x;
    if (u < NU_P) { ATTN_DECODE(u, s0, b0, kh0, qb0); (void)s0; attn_load<false>(p, b0, kh0, qb0, R); }
    for (; u < NU_P; u += G) {
        ATTN_DECODE(u, samp, b, kh, qb); (void)samp;
        bf16x8 qf[4]; attn_load_q<false>(p, b, kh, qb, qf);
        __syncthreads();
        attn_stage(Ks, Vt, R);
        const float sink = R.sink;
        __syncthreads();
        if (u + G < NU_P) { ATTN_DECODE(u + G, s2, b2, kh2, qb2); (void)s2; attn_load<false>(p, b2, kh2, qb2, R); }
        attn_math(p, Ks, Vt, qf, sink, false, b, kh, qb);
    }
    for (; u < NU; u += G) {
        ATTN_DECODE(u, samp, b, kh, qb); (void)samp;
        attn_load<true>(p, b, kh, qb, R);
        bf16x8 qf[4]; attn_load_q<true>(p, b, kh, qb, qf);
        __syncthreads();
        attn_stage(Ks, Vt, R);
        __syncthreads();
        attn_math(p, Ks, Vt, qf, R.sink, true, b, kh, qb);
    }
}

__device__ __forceinline__ void fold_sample(const Params& p, unsigned* cnt, const float* gain, float* rowss, LAS unsigned char* lds, int G) {
    const int tid = threadIdx.x, lane = tid & 63, wave = tid >> 6;
    if (tid == 0) { unsigned sp = 0; while (__hip_atomic_load(cnt, __ATOMIC_RELAXED, __HIP_MEMORY_SCOPE_AGENT) < 256u) { __builtin_amdgcn_s_sleep(2); if (++sp > (1u << 22)) break; }
        __builtin_amdgcn_fence(__ATOMIC_ACQUIRE, "agent"); asm volatile("s_waitcnt vmcnt(0)" ::: "memory"); }
    __syncthreads();
    float* X = (float*)(p.ws + WS_X); bf16_t* H = (bf16_t*)(p.ws + WS_H); const float* slab = (const float*)(p.ws + WS_SLAB);
    LAS float* red = (LAS float*)lds;
    for (int hr = blockIdx.x; hr < 2 * MS; hr += G) {
        const int srow = hr >> 1, col = (hr & 1) * 2048 + tid * 4;
        float* xq = X + (size_t)(MP + srow) * DM + col;
        f32x4 v = *(const f32x4*)xq;
        const bf16_t* sp = (const bf16_t*)slab + (size_t)srow * DM + col;
#pragma unroll
        for (int q = 0; q < S_RES; ++q) { const u32x2 w = *(const u32x2*)(sp + (size_t)q * 128 * DM); v += (f32x4){bflo(w.x), bfhi(w.x), bflo(w.y), bfhi(w.y)}; }
        *(f32x4*)xq = v;
        if (gain) {
        const f32x4 h = v * *(const f32x4*)(gain + col);
        *(u32x2*)(H + (size_t)(MP + srow) * DM + col) = (u32x2){cvtpk(h.x, h.y), cvtpk(h.z, h.w)};
        const float ss = wave_sum((v.x * v.x + v.y * v.y) + (v.z * v.z + v.w * v.w));
        if (lane == 0) red[wave] = ss;
        __syncthreads();
        if (tid == 0) unsafeAtomicAdd(rowss + MP + srow, ((red[0] + red[1]) + (red[2] + red[3])) + ((red[4] + red[5]) + (red[6] + red[7])));
        __syncthreads(); }
    }
}

__device__ __forceinline__ void fold_bf16(const Params& p, unsigned* cnt, unsigned need, int parts, int ncols, bf16_t* dst, int ldd, int col0, const float* rowss, int G, int gu_pn0 = -1) {
    const int tid = threadIdx.x;
    if (tid == 0) { unsigned sp = 0; while (__hip_atomic_load(cnt, __ATOMIC_RELAXED, __HIP_MEMORY_SCOPE_AGENT) < need) { __builtin_amdgcn_s_sleep(2); if (++sp > (1u << 22)) break; }
        __builtin_amdgcn_fence(__ATOMIC_ACQUIRE, "agent"); asm volatile("s_waitcnt vmcnt(0)" ::: "memory"); }
    __syncthreads();
    const float* slab = (const float*)(p.ws + WS_SLAB);
    const int cpr = ncols / 8;
    for (int ch = blockIdx.x * NTHR + tid; ch < MS * cpr; ch += G * NTHR) {
        const int srow = ch / cpr, c = (ch - srow * cpr) * 8;
        const bf16_t* sp = (const bf16_t*)slab + (size_t)srow * ncols + c;
        f32x4 a = {0.f, 0.f, 0.f, 0.f}, b = {0.f, 0.f, 0.f, 0.f};
        for (int q = 0; q < parts; ++q) { const u32x4 w = *(const u32x4*)sp; a += (f32x4){bflo(w.x), bfhi(w.x), bflo(w.y), bfhi(w.y)}; b += (f32x4){bflo(w.z), bfhi(w.z), bflo(w.w), bfhi(w.w)}; sp += (size_t)128 * ncols; }
        const float rs = rowss ? 1.0f / sqrtf(rowss[MP + srow] * (1.0f / DM) + EPS) : 1.0f;
        a *= rs; b *= rs;
        const int dcol = gu_pn0 < 0 ? col0 + c : ((c >> 7) & 1) * DFF + (gu_pn0 + (c >> 8)) * 128 + (c & 127);
        *(u32x4*)(dst + (size_t)(MP + srow) * ldd + dcol) = (u32x4){cvtpk(a.x, a.y), cvtpk(a.z, a.w), cvtpk(b.x, b.y), cvtpk(b.z, b.w)};
    }
}

constexpr int NPHASE = 19;
__global__ void __launch_bounds__(NTHR, 2) trunk_fwd(Params p) {
    extern __shared__ __attribute__((aligned(16))) unsigned char lds_raw[];
    LAS unsigned char* lds = (LAS unsigned char*)lds_raw;
    volatile LAS unsigned* MISC = (volatile LAS unsigned*)(lds + MISC_OFF);
    const int tid = threadIdx.x, G = gridDim.x;
    unsigned char* ws = p.ws;
    for (int u = tid; u < (LDS_BYTES - LDSCTL_OFF) / 4; u += NTHR) ((LAS unsigned*)(lds + LDSCTL_OFF))[u] = 0u;
    __syncthreads();
#if MK_SPLIT
#define GRID_BAR() do { } while (0)
#else
    XcdBarrier bar = xcd_barrier_post((unsigned*)(ws + WS_CTL) + CW_BAR, MISC + 8);
#define GRID_BAR() do { if (BG_CONV) xcd_barrier_bg(bar, p, lds); else xcd_barrier(bar); } while (0)
#endif
    const int lo = p.ph_lo, hi = p.ph_hi;
#define IN(k) (lo <= (k) && (k) < hi)
#define BG_DL(k) ((k) == 4 ? BQ_UP0 : (k) == 7 ? BQ_DN0 : (k) == 8 ? BQ_QKV : (k) == 12 ? BQ_O : (k) == 13 ? BQ_UP1 : (k) == 16 ? BQ_DN1 : 0)
#define SEAM(k) do { if ((k) + 1 < hi) { if (BG_CONV != 0 && BG_DL(k) != 0) bg_drain(p, lds, MISC + 8, BG_DL(k)); GRID_BAR(); } } while (0)
    const bf16_t* Hb = (const bf16_t*)(ws + WS_H);
    float* X = (float*)(ws + WS_X);
    float* slab = (float*)(ws + WS_SLAB);

    const float* IG = (const float*)(ws + WS_IGAIN);
    float* RS = (float*)(ws + WS_ROWSS);
    unsigned* FC = (unsigned*)(ws + WS_CTL) + CW_FOLD;
    bf16_t* Hw = (bf16_t*)(ws + WS_H);

    if (IN(0)) { REP(0) { prologue_phase(p, lds, G); cache_copy(p, G); norm_phase<0>(p, p.in[I_NMIX], G); } SEAM(0); }
    if (IN(1)) {
        pg8::Gemm g{Hb, (const bf16_t*)(ws + WS_WIN), DM, DM}; pg8::StaticOrder S; S.init(NIN, DM, DM, DM, 0, S_IN, G, (int)blockIdx.x, 1);
        pg8::EpiBf16 E{(bf16_t*)(ws + WS_PROJ), NIN, 0, nullptr, nullptr, nullptr};
        pg8::gemm_phase(lds, g, S, E, slab, NIN, 0, FC + 192); fold_bf16(p, FC + 192, 256u, S_IN, NIN, (bf16_t*)(ws + WS_PROJ), NIN, 0, nullptr, G); SEAM(1); }
    if (IN(2)) { REP(2) mixer_phase(p, G); SEAM(2); }
    if (IN(3)) {
        pg8::Gemm g{(const bf16_t*)(ws + WS_POOLED), (const bf16_t*)(ws + WS_WPOOL), DB, PGRP}; pg8::PoolOrder S; S.init(G, (int)blockIdx.x);
        pg8::EpiBf16 E{(bf16_t*)(ws + WS_CAT) + DA, DM, PGRP, nullptr, p.in[I_PSCALE], nullptr};
        pg8::gemm_phase(lds, g, S, E, slab, 0, 0); SEAM(3); }
    if (IN(4)) {
        pg8::Gemm g{(const bf16_t*)(ws + WS_CAT), (const bf16_t*)(ws + WS_WOUT), DM, DM}; pg8::StaticOrder S; S.init(DM, DM, DM, DM, 0, S_RES, G, (int)blockIdx.x, 1);
        pg8::EpiResid E{Hw, IG + 3 * DM, RS + 4 * MPAD, Hw, p.in[I_NFFN], RS};
        pg8::gemm_phase(lds, g, S, E, slab, DM, 0, FC); fold_sample(p, FC, p.in[I_NFFN], RS, lds, G); SEAM(4); }
    if (IN(6)) {
        pg8::Gemm g{Hb, (const bf16_t*)(ws + WS_WUP), DM, DM}; pg8::StaticOrder S; S.init(NUP, DM, DM, DM, UP_PNSPLIT, S_UP, G, (int)blockIdx.x, 1, pg8::HALF);
        pg8::EpiUpConv E{(bf16_t*)(ws + WS_U), (bf16_t*)(ws + WS_ACT), (bf16_t*)(ws + WS_HALO), RS, p.in[I_CONVF] + (size_t)0 * 3 * NUP, p.out + O_F_P + (size_t)0 * NBP * 2 * NUP};
        pg8::gemm_phase(lds, g, S, E, slab, NUP - UP_PNSPLIT * 256, UP_PNSPLIT, FC + 256);
        fold_bf16(p, FC + 256, (unsigned)((NUP / 256 - UP_PNSPLIT) * S_UP), S_UP, NUP - UP_PNSPLIT * 256, (bf16_t*)(ws + WS_U), NUP, 0, RS, G, UP_PNSPLIT); SEAM(6); }
    if (IN(7)) { ffnfix_phase(p, 0, G); SEAM(7); }
    if (IN(8)) {
        pg8::Gemm g{(const bf16_t*)(ws + WS_ACT), (const bf16_t*)(ws + WS_WDN), DFF, DFF}; pg8::StaticOrder S; S.init(DM, DFF, DFF, DFF, 0, S_RES, G, (int)blockIdx.x, 1);
        pg8::EpiResid E{Hw, IG, nullptr, Hw, p.in[I_NMIX] + DM, RS + MPAD};
        pg8::gemm_phase(lds, g, S, E, slab, DM, 0, FC + 64); fold_sample(p, FC + 64, p.in[I_NMIX] + DM, RS + MPAD, lds, G); SEAM(8); }
    if (IN(10)) {
        pg8::Gemm g{Hb, (const bf16_t*)(ws + WS_WQKV), DM, DM}; pg8::StaticOrder S; S.init(NQKV, DM, DM, DM, NQKV / 256, 1, G, (int)blockIdx.x);
        pg8::EpiQKV E{(bf16_t*)(ws + WS_PROJ), p.in[I_BQKV], RS + MPAD, (const f32x4*)(ws + WS_ROPE), p.out};
        pg8::gemm_phase(lds, g, S, E, slab, 0, 0); SEAM(10); }
    if (IN(12)) { REP(12) attn_phase(p, lds, G); SEAM(12); }
    if (IN(13)) {
        pg8::Gemm g{(const bf16_t*)(ws + WS_CAT), (const bf16_t*)(ws + WS_WO), DM, DM}; pg8::StaticOrder S; S.init(DM, DM, DM, DM, 0, S_RES, G, (int)blockIdx.x, 1);
        pg8::EpiResid E{Hw, IG + DM, nullptr, Hw, p.in[I_NFFN] + DM, RS + 2 * MPAD};
        pg8::gemm_phase(lds, g, S, E, slab, DM, 0, FC + 128); fold_sample(p, FC + 128, p.in[I_NFFN] + DM, RS + 2 * MPAD, lds, G); SEAM(13); }
    if (IN(15)) {
        pg8::Gemm g{Hb, (const bf16_t*)(ws + WS_WUP) + WUP_STRIDE, DM, DM}; pg8::StaticOrder S; S.init(NUP, DM, DM, DM, UP_PNSPLIT, S_UP, G, (int)blockIdx.x, 1, pg8::HALF);
        pg8::EpiUpConv E{(bf16_t*)(ws + WS_U), (bf16_t*)(ws + WS_ACT), (bf16_t*)(ws + WS_HALO), RS + 2 * MPAD, p.in[I_CONVF] + (size_t)1 * 3 * NUP, p.out + O_F_P + (size_t)1 * NBP * 2 * NUP};
        pg8::gemm_phase(lds, g, S, E, slab, NUP - UP_PNSPLIT * 256, UP_PNSPLIT, FC + 320);
        fold_bf16(p, FC + 320, (unsigned)((NUP / 256 - UP_PNSPLIT) * S_UP), S_UP, NUP - UP_PNSPLIT * 256, (bf16_t*)(ws + WS_U), NUP, 0, RS + 2 * MPAD, G, UP_PNSPLIT); SEAM(15); }
    if (IN(16)) { ffnfix_phase(p, 1, G); SEAM(16); }
    if (IN(17)) {
        pg8::Gemm g{(const bf16_t*)(ws + WS_ACT), (const bf16_t*)(ws + WS_WDN) + WDN_STRIDE, DFF, DFF}; pg8::StaticOrder S; S.init(DM, DFF, DFF, DFF, 0, S_RES, G, (int)blockIdx.x, 1);
        pg8::EpiResid E{Hw, IG + 2 * DM, nullptr, Hw, p.in[I_NFIN], RS + 3 * MPAD};
        pg8::gemm_phase(lds, g, S, E, slab, DM, 0, FC + 384); fold_sample(p, FC + 384, nullptr, nullptr, lds, G); SEAM(17); }
    if (IN(18)) { norm_phase<2>(p, p.in[I_NFIN], G); }
#undef IN
#undef SEAM
#undef GRID_BAR
}

extern "C" void kernel_launch(void* const* d_in, const int* in_sizes, int n_in, void* d_out, int out_size, void* d_ws, size_t ws_size, hipStream_t stream) {
    static int grid = 0;
    if (grid == 0) {
        if (n_in != 22 || (size_t)out_size != O_END || ws_size < WS_END) { fprintf(stderr, "kernel_launch: unexpected shapes: n_in %d out %d (want %zu) ws %zu (need %zu); nothing launched\n", n_in, out_size, (size_t)O_END, ws_size, (size_t)WS_END); grid = -1; return; }
        int dev = 0, cus = 0, per_cu = 0;
        if (hipGetDevice(&dev) != hipSuccess || hipDeviceGetAttribute(&cus, hipDeviceAttributeMultiprocessorCount, dev) != hipSuccess) { grid = -1; return; }
        if (hipFuncSetAttribute((const void*)trunk_fwd, hipFuncAttributeMaxDynamicSharedMemorySize, LDS_BYTES) != hipSuccess) { fprintf(stderr, "kernel_launch: hipFuncSetAttribute failed\n"); grid = -1; return; }
        if (hipOccupancyMaxActiveBlocksPerMultiprocessor(&per_cu, (const void*)trunk_fwd, NTHR, LDS_BYTES) != hipSuccess || per_cu < 1) fprintf(stderr, "kernel_launch: occupancy query reports %d\n", per_cu);
        (void)hipGetLastError();
        grid = cus;
    }
    if (grid < 0) return;
    (void)hipMemsetAsync((char*)d_ws + WS_CTL, 0, CTL_ZERO_BYTES, stream);
    Params a{};
    for (int i = 0; i < 22; ++i) a.in[i] = (const float*)d_in[i];
    a.out = (float*)d_out; a.ws = (unsigned char*)d_ws;
#if MK_SPLIT
    for (int ph = 0; ph < NPHASE; ++ph) { a.ph_lo = ph; a.ph_hi = ph + 1; hipLaunchKernelGGL(trunk_fwd, dim3(grid), dim3(NTHR), LDS_BYTES, stream, a); }
#else
    a.ph_lo = 0; a.ph_hi = NPHASE;
    hipLaunchKernelGGL(trunk_fwd, dim3(grid), dim3(NTHR), LDS_BYTES, stream, a);
#endif
}
```

```cpp
#include <hip/hip_runtime.h>
#include <cstdio>
#include <cstdint>

#ifndef PROBE_DUP_GEMM
#define PROBE_DUP_GEMM 0
#endif
#ifndef PROBE_DUP_MASK
#define PROBE_DUP_MASK 0
#endif
#define REP(k) for (int _r = 0; _r < 1 + ((PROBE_DUP_MASK >> (k)) & 1); ++_r)
#ifndef CONV_IN_P0
#define CONV_IN_P0 1
#endif
#ifndef BG_CONV
#define BG_CONV 1
#endif
#ifndef MK_SPLIT
#define MK_SPLIT 0
#endif

#define GAS __attribute__((address_space(1)))
#define LAS __attribute__((address_space(3)))
typedef unsigned short bf16_t;
typedef short bf16x8 __attribute__((ext_vector_type(8)));
typedef float f32x4 __attribute__((ext_vector_type(4)));
typedef float f32x2 __attribute__((ext_vector_type(2)));
typedef float f32x16 __attribute__((ext_vector_type(16)));
typedef unsigned u32x4 __attribute__((ext_vector_type(4)));
typedef unsigned u32x2 __attribute__((ext_vector_type(2)));
typedef __bf16 bf16x2_t __attribute__((ext_vector_type(2)));

constexpr int DM = 4096;
constexpr int MP = 8192, MS = 128, MR = MP + MS, MPAD = 8448, NPANEL = MPAD / 256;
constexpr int TP = 2048, NBP = 4, NBS = 32, TS = 4, PAST = 16384;
constexpr int DA = 2048, DB = 2048, NIN = 8192, PGRP = 512;
constexpr int DFF = 11008, NUP = 22016;
constexpr int NQKV = 5120, NH = 64, NKV = 8, HD = 64, WIN = 128;
constexpr float EPS = 1e-6f;

constexpr size_t O_Y = 0;
constexpr size_t O_CA_P = (size_t)MR * DM;
constexpr size_t O_CA_S = O_CA_P + 4 * 2 * 2048;
constexpr size_t O_PL_P = O_CA_S + 32 * 2 * 2048;
constexpr size_t O_PL_S = O_PL_P + 4 * 15 * 2048;
constexpr size_t O_K_P = O_PL_S + 32 * 15 * 2048;
constexpr size_t O_K_S = O_K_P + 4 * 128 * 512;
constexpr size_t O_V_P = O_K_S + 32 * 128 * 512;
constexpr size_t O_V_S = O_V_P + 4 * 128 * 512;
constexpr size_t O_F_P = O_V_S + 32 * 128 * 512;
constexpr size_t O_F_S = O_F_P + (size_t)2 * 4 * 2 * NUP;
constexpr size_t O_END = O_F_S + (size_t)2 * 32 * 2 * NUP;

constexpr size_t MiB = 1u << 20;
constexpr size_t al(size_t x) { return (x + MiB - 1) / MiB * MiB; }
constexpr size_t WS_CTL = 0, CTL_ZERO_BYTES = 1 * MiB;
constexpr size_t WS_ROPE = 1 * MiB;
constexpr size_t WS_WIN = 2 * MiB;
constexpr size_t WS_WPOOL = WS_WIN + al((size_t)NIN * DM * 2);
constexpr size_t WS_WOUT = WS_WPOOL + al((size_t)4 * 512 * 512 * 2);
constexpr size_t WS_WQKV = WS_WOUT + al((size_t)DM * DM * 2);
constexpr size_t WS_WO = WS_WQKV + al((size_t)NQKV * DM * 2);
constexpr size_t WS_WUP = WS_WO + al((size_t)DM * DM * 2);
constexpr size_t WUP_STRIDE = (size_t)NUP * DM;
constexpr size_t WS_WDN = WS_WUP + al(2 * WUP_STRIDE * 2);
constexpr size_t WDN_STRIDE = (size_t)DM * DFF;
constexpr size_t WS_X = WS_WDN + al(2 * WDN_STRIDE * 2);
constexpr size_t WS_H = WS_X + al((size_t)MPAD * DM * 4);
constexpr size_t WS_PROJ = WS_H + al((size_t)MPAD * DM * 2);
constexpr size_t WS_CAT = WS_PROJ + al((size_t)MPAD * NIN * 2);
constexpr size_t WS_POOLED = WS_CAT + al((size_t)MPAD * DM * 2);
constexpr size_t WS_U = WS_POOLED + al((size_t)MPAD * DB * 2);
constexpr size_t WS_ACT = WS_U + al((size_t)MPAD * NUP * 2);
constexpr size_t WS_SLAB = WS_ACT + al((size_t)MPAD * DFF * 2);
constexpr size_t WS_HALO = WS_SLAB + 32 * MiB;
constexpr size_t WS_END = WS_HALO + al((size_t)32 * 16 * NUP * 4);
constexpr size_t WS_ROWSS = WS_ROPE + 640 * 1024;
constexpr size_t WS_IGAIN = WS_ROPE + 900 * 1024;
constexpr int CW_FOLD = 8192;
constexpr int CW_BAR = 4096;

constexpr int RING_BYTES = 131072;
constexpr int LDS_BYTES = 147456;
constexpr int WLDS_OFF = 131072;
constexpr int LDSCTL_OFF = LDS_BYTES - 1024, MISC_OFF = LDSCTL_OFF + 320;
constexpr int NWAVES = 8, NTHR = 512;

__device__ __forceinline__ unsigned cvtpk(float lo, float hi) { f32x2 v = {lo, hi}; bf16x2_t b = __builtin_convertvector(v, bf16x2_t); return __builtin_bit_cast(unsigned, b); }
__device__ __forceinline__ float bflo(unsigned w) { return __uint_as_float(w << 16); }
__device__ __forceinline__ float bfhi(unsigned w) { return __uint_as_float(w & 0xffff0000u); }
__device__ __forceinline__ void load8(const bf16_t* p, float (&v)[8]) {
    const u32x4 w = *(const u32x4*)p;
    v[0] = bflo(w.x); v[1] = bfhi(w.x); v[2] = bflo(w.y); v[3] = bfhi(w.y); v[4] = bflo(w.z); v[5] = bfhi(w.z); v[6] = bflo(w.w); v[7] = bfhi(w.w);
}
__device__ __forceinline__ void store8(bf16_t* p, const float (&v)[8]) {
    u32x4 w; w.x = cvtpk(v[0], v[1]); w.y = cvtpk(v[2], v[3]); w.z = cvtpk(v[4], v[5]); w.w = cvtpk(v[6], v[7]);
    *(u32x4*)p = w;
}
__device__ __forceinline__ void loadf8(const float* p, float (&v)[8]) {
    const f32x4 a = *(const f32x4*)p, b = *(const f32x4*)(p + 4);
    v[0] = a.x; v[1] = a.y; v[2] = a.z; v[3] = a.w; v[4] = b.x; v[5] = b.y; v[6] = b.z; v[7] = b.w;
}
__device__ __forceinline__ void storef8(float* p, const float (&v)[8]) {
    *(f32x4*)p = (f32x4){v[0], v[1], v[2], v[3]}; *(f32x4*)(p + 4) = (f32x4){v[4], v[5], v[6], v[7]};
}
__device__ __forceinline__ float wave_sum(float v) {
#pragma unroll
    for (int o = 1; o < 64; o <<= 1) v += __shfl_xor(v, o);
    return v;
}

namespace pg8 {
constexpr int BM = 256, BK = 64, HALF = 128, HTB = HALF * BK * 2, STAGE_BYTES = 8 * HTB, NXCD = 8, WGM = 8;
__host__ __device__ __forceinline__ int lds_byte(int r, int c) { const int st = (r >> 4) * 2 + (c >> 5), rr = r & 15, cc = c & 31, ob = rr * 64 + cc * 2; return st * 1024 + (ob ^ (((ob >> 9) & 1) << 5)); }
__host__ __device__ __forceinline__ void stage_rc(int b, int& R, int& C) { const int st = b / 1024, sb = b % 1024, swz = sb ^ (((sb >> 9) & 1) << 5); R = (st >> 1) * 16 + swz / 64; C = (st & 1) * 32 + (swz % 64) / 2; }
__host__ __device__ __forceinline__ int perm32(int rho) { const int n = rho >> 4, i = rho & 15; return 8 * (i >> 2) + 4 * n + (i & 3); }

struct Unit { int pm, pn, g, nkt, mode, sidx; size_t ao, bo; };
struct Gemm { const bf16_t* A; const bf16_t* Bt; int lda, ldb; };

struct StaticOrder {
    int nN, nwgP, nDP, ntot, G, c, npair, pnsplit, s, sfirst; size_t tA, tB;
    __device__ void init(int N, int K, int lda, int ldb, int pnsplit_, int s_, int G_, int c_, int sfirst_ = 0, int brows = BM) { sfirst = sfirst_;   nN = N / BM; nwgP = 32 * nN; pnsplit = pnsplit_; s = s_; nDP = nwgP + pnsplit; ntot = nDP + (nN - pnsplit) * s; G = G_; c = c_; npair = K / (2 * BK);
        tA = (size_t)BM * lda * 2; tB = (size_t)brows * ldb * 2; }
    __device__ bool next(int i, Unit& u) const {
        int L = i * G + c;
        if (sfirst) { const int nsub = ntot - nDP; if (c < nsub) { if (i == 0) L = nDP + c; else { L = (i - 1) * G + c; if (L >= nDP) return false; } } else if (L >= nDP) return false; }
        if (L >= ntot) return false;
        u.g = 0; u.mode = 0; u.sidx = 0; u.nkt = 2 * npair;
        if (L < nwgP) {
            int wgid = L; { const int q = nwgP / NXCD, xcd = wgid % NXCD, off = wgid / NXCD; wgid = xcd * q + off; }
            const int nig = WGM * nN, gid = wgid / nig, fm = gid * WGM;
            u.pm = fm + ((wgid % nig) % WGM); u.pn = (wgid % nig) / WGM; u.ao = (size_t)u.pm * tA; u.bo = (size_t)u.pn * tB;
        } else if (L < nDP) { u.pm = 32; u.pn = L - nwgP; u.ao = 32 * tA; u.bo = (size_t)u.pn * tB; }
        else { const int L2 = L - nDP, t = L2 / s, part = L2 - t * s, p0 = npair * part / s, p1 = npair * (part + 1) / s;
            u.pm = 32; u.pn = pnsplit + t; u.nkt = 2 * (p1 - p0); u.mode = 1; u.sidx = part; u.ao = 32 * tA + (size_t)p0 * 256; u.bo = (size_t)u.pn * tB + (size_t)p0 * 256; }
        return true;
    }
};
struct PoolOrder {
    int G, c;
    __device__ void init(int G_, int c_) { G = G_; c = c_; }
    __device__ bool next(int i, Unit& u) const {
        const int L = i * G + c; if (L >= 4 * NPANEL * 2) return false;
        if (L < 256) { u.g = L >> 6; u.pm = (L & 63) >> 1; u.pn = L & 1; } else { const int L2 = L - 256; u.g = L2 >> 1; u.pm = 32; u.pn = L2 & 1; }
        u.nkt = PGRP / BK; u.mode = 0; u.sidx = 0;
        u.ao = ((size_t)u.pm * BM * DB + (size_t)u.g * PGRP) * 2; u.bo = ((size_t)u.g * PGRP + (size_t)u.pn * BM) * PGRP * 2; return true;
    }
};

struct EpiBf16 {
    static constexpr bool PERM = true; static constexpr int BMODE = 1; static constexpr int AMODE = 0;
    bf16_t* O; int ldc; int gcol; const float* bias; const float* scale; const float* rowss;
    __device__ __forceinline__ void operator()(const f32x4 (&acc)[2][2][4][2], const Unit& u, int wr, int wc, int fr, int fq) const {
        const int row0 = u.pm * BM + wr * 64 + fr; const int col0 = u.g * gcol + u.pn * BM + wc * 32 + 8 * fq;
        f32x4 bv[2][2], sv[2][2];
#pragma unroll
        for (int bj = 0; bj < 2; ++bj)
#pragma unroll
            for (int n = 0; n < 2; ++n) { bv[bj][n] = bias ? *(const f32x4*)(bias + col0 + bj * HALF + 4 * n) : (f32x4){0.f, 0.f, 0.f, 0.f};
                                          sv[bj][n] = scale ? *(const f32x4*)(scale + col0 + bj * HALF + 4 * n) : (f32x4){1.f, 1.f, 1.f, 1.f}; }
#pragma unroll
        for (int ai = 0; ai < 2; ++ai)
#pragma unroll
            for (int m = 0; m < 4; ++m) { bf16_t* rowp = O + (size_t)(row0 + ai * HALF + m * 16) * ldc + col0;
                const float rs = rowss ? 1.0f / sqrtf(rowss[row0 + ai * HALF + m * 16] * (1.0f / DM) + EPS) : 1.0f;
#pragma unroll
                for (int bj = 0; bj < 2; ++bj) { const f32x4 v0 = (acc[ai][bj][m][0] * rs + bv[bj][0]) * sv[bj][0], v1 = (acc[ai][bj][m][1] * rs + bv[bj][1]) * sv[bj][1];
                    u32x4 w; w.x = cvtpk(v0[0], v0[1]); w.y = cvtpk(v0[2], v0[3]); w.z = cvtpk(v1[0], v1[1]); w.w = cvtpk(v1[2], v1[3]);
                    *(u32x4*)(rowp + bj * HALF) = w; } }
    }
};
struct EpiUpU {
    static constexpr bool PERM = true; static constexpr int BMODE = 3; static constexpr int AMODE = 0; static constexpr bool PUBLISH = false;
    bf16_t* O; const float* rowss;
    __device__ __forceinline__ void operator()(const f32x4 (&acc)[2][2][4][2], const Unit& u, int wr, int wc, int fr, int fq) const {
        const int row0 = u.pm * BM + wr * 64 + fr, ch0 = u.pn * HALF + wc * 32 + 8 * fq;
#pragma unroll
        for (int ai = 0; ai < 2; ++ai)
#pragma unroll
            for (int m = 0; m < 4; ++m) { const int row = row0 + ai * HALF + m * 16; bf16_t* rowp = O + (size_t)row * NUP + ch0;
                const float rs = 1.0f / sqrtf(rowss[row] * (1.0f / DM) + EPS);
#pragma unroll
                for (int bj = 0; bj < 2; ++bj) { const f32x4 v0 = acc[ai][bj][m][0] * rs, v1 = acc[ai][bj][m][1] * rs;
                    *(u32x4*)(rowp + bj * DFF) = (u32x4){cvtpk(v0[0], v0[1]), cvtpk(v0[2], v0[3]), cvtpk(v1[0], v1[1]), cvtpk(v1[2], v1[3])}; } }
    }
};
__device__ __forceinline__ f32x4 dpp_shr1(f32x4 v) { f32x4 r;
#pragma unroll
    for (int i = 0; i < 4; ++i) r[i] = __int_as_float(__builtin_amdgcn_update_dpp(0, __float_as_int(v[i]), 0x111, 0xf, 0xf, false)); return r; }
struct EpiUpConv {
    static constexpr bool PERM = true; static constexpr int BMODE = 3; static constexpr int AMODE = 1; static constexpr bool PUBLISH = false;
    bf16_t* U; bf16_t* ACT; bf16_t* halo; const float* rowss; const float* cw; float* fout;
    __device__ __forceinline__ void stage(LAS unsigned char* dst, const Unit& u, int wid, int lane) const {
        if (wid < 3 && u.pm != 32) __builtin_amdgcn_global_load_lds((const unsigned*)(cw + (size_t)wid * NUP + (lane >> 5) * DFF + u.pn * HALF + 4 * (lane & 31)), (LAS unsigned*)(dst + wid * 1024), 16, 0, 0);
    }
    __device__ __forceinline__ void operator()(const f32x4 (&acc)[2][2][4][2], const Unit& u, int wr, int wc, int fr, int fq, const LAS float* wl) const {
        const int rb = u.pm * BM + wr * 64 + 4 * fr, ch0 = u.pn * HALF + wc * 32 + 8 * fq;
        if (u.pm == 32) {
            const f32x4 ss = *(const f32x4*)(rowss + rb);
#pragma unroll
            for (int m = 0; m < 4; ++m) { bf16_t* rowp = U + (size_t)(rb + m) * NUP + ch0;
                const float rs = __builtin_amdgcn_rsqf(ss[m] * (1.0f / DM) + EPS);
#pragma unroll
                for (int bj = 0; bj < 2; ++bj) { const f32x4 v0 = acc[0][bj][m][0] * rs, v1 = acc[0][bj][m][1] * rs;
                    *(u32x4*)(rowp + bj * DFF) = (u32x4){cvtpk(v0[0], v0[1]), cvtpk(v0[2], v0[3]), cvtpk(v1[0], v1[1]), cvtpk(v1[2], v1[3])}; } }
            return;
        }
        const bool f0 = fr == 0, f15 = fr == 15;
        const f32x4 ssq[2] = {*(const f32x4*)(rowss + rb), *(const f32x4*)(rowss + rb + HALF)};
        const LAS float* wlc = wl + wc * 32 + 8 * fq;
#pragma unroll
        for (int ai = 0; ai < 2; ++ai) {
            const int blk = ai * 2 + wr;
            const f32x4 ss = ssq[ai];
            f32x4 rs;
#pragma unroll
            for (int m = 0; m < 4; ++m) rs[m] = __builtin_amdgcn_rsqf(ss[m] * (1.0f / DM) + EPS);
#pragma unroll
            for (int n = 0; n < 2; ++n) {
                bf16_t* hb = halo + ((size_t)(u.pm * 4 + blk) * 4) * NUP + ch0 + 4 * n;
                f32x4 cg[4];
#pragma unroll
                for (int bj = 0; bj < 2; ++bj) {
                    f32x4 w[3];
#pragma unroll
                    for (int k = 0; k < 3; ++k) w[k] = *(const LAS f32x4*)(wlc + k * 256 + bj * 128 + 4 * n);
                    f32x4 x[4];
#pragma unroll
                    for (int m = 0; m < 4; ++m) x[m] = acc[ai][bj][m][n] * rs[m];
                    if (f0) { *(u32x2*)(hb + bj * DFF) = (u32x2){cvtpk(x[0][0], x[0][1]), cvtpk(x[0][2], x[0][3])}; *(u32x2*)(hb + (size_t)NUP + bj * DFF) = (u32x2){cvtpk(x[1][0], x[1][1]), cvtpk(x[1][2], x[1][3])}; }
                    if (f15) { *(u32x2*)(hb + (size_t)2 * NUP + bj * DFF) = (u32x2){cvtpk(x[2][0], x[2][1]), cvtpk(x[2][2], x[2][3])}; *(u32x2*)(hb + (size_t)3 * NUP + bj * DFF) = (u32x2){cvtpk(x[3][0], x[3][1]), cvtpk(x[3][2], x[3][3])};
                        if ((u.pm & 7) == 7 && blk == 3) { float* fo = fout + ((size_t)(u.pm >> 3) * 2) * NUP + bj * DFF + ch0 + 4 * n; *(f32x4*)fo = x[2]; *(f32x4*)(fo + NUP) = x[3]; } }
                    const f32x4 s2 = dpp_shr1(x[2]), s3 = dpp_shr1(x[3]);
                    if (bj == 0) {
                        cg[0] = s2 * w[0] + s3 * w[1] + x[0] * w[2];
                        cg[1] = s3 * w[0] + x[0] * w[1] + x[1] * w[2];
                        cg[2] = x[0] * w[0] + x[1] * w[1] + x[2] * w[2];
                        cg[3] = x[1] * w[0] + x[2] * w[1] + x[3] * w[2];
                        asm volatile("" ::: "memory");
                    } else {
#pragma unroll
                        for (int m = 0; m < 4; ++m) {
                            const f32x4 cu = (m == 0 ? s2 : m == 1 ? s3 : x[m - 2]) * w[0] + (m == 0 ? s3 : x[m > 0 ? m - 1 : 0]) * w[1] + x[m] * w[2];
                            f32x4 a;
#pragma unroll
                            for (int i = 0; i < 4; ++i) a[i] = cg[m][i] * __builtin_amdgcn_rcpf(1.0f + __expf(-cg[m][i])) * cu[i];
                            if (!(m < 2 && f0)) *(u32x2*)(ACT + (size_t)(rb + ai * HALF + m) * DFF + ch0 + 4 * n) = (u32x2){cvtpk(a[0], a[1]), cvtpk(a[2], a[3])};
                            asm volatile("" ::: "memory");
                        }
                    }
                }
                asm volatile("" ::: "memory");
            }
        }
    }
};
struct EpiResid {
    static constexpr bool PERM = true; static constexpr int BMODE = 1; static constexpr int AMODE = 0;
    const bf16_t* Hold; const float* igain; const float* rowf; bf16_t* H; const float* gain; float* rowss;
    __device__ __forceinline__ void operator()(const f32x4 (&acc)[2][2][4][2], const Unit& u, int wr, int wc, int fr, int fq) const {
        const int row0 = u.pm * BM + wr * 64 + fr, col0 = u.pn * BM + wc * 32 + 8 * fq;
        f32x4 gv[2][2], iv[2][2];
#pragma unroll
        for (int bj = 0; bj < 2; ++bj)
#pragma unroll
            for (int n = 0; n < 2; ++n) { gv[bj][n] = *(const f32x4*)(gain + col0 + bj * HALF + 4 * n); iv[bj][n] = *(const f32x4*)(igain + col0 + bj * HALF + 4 * n); }
        float rf[8];
#pragma unroll
        for (int g = 0; g < 8; ++g) rf[g] = rowf ? sqrtf(rowf[row0 + (g >> 2) * HALF + (g & 3) * 16] * (1.0f / DM) + EPS) : 1.0f;
#pragma unroll
        for (int ai = 0; ai < 2; ++ai)
#pragma unroll
            for (int m = 0; m < 4; ++m) { const int row = row0 + ai * HALF + m * 16;
                const size_t ro = (size_t)row * DM + col0;
                float ss = 0.f;
#pragma unroll
                for (int bj = 0; bj < 2; ++bj) {
                    const u32x4 w = *(const u32x4*)(Hold + ro + bj * HALF);
                    const f32x4 b0 = (f32x4){bflo(w.x), bfhi(w.x), bflo(w.y), bfhi(w.y)} * (iv[bj][0] * rf[ai * 4 + m]), b1 = (f32x4){bflo(w.z), bfhi(w.z), bflo(w.w), bfhi(w.w)} * (iv[bj][1] * rf[ai * 4 + m]);
                    const f32x4 v0 = b0 + acc[ai][bj][m][0], v1 = b1 + acc[ai][bj][m][1];
                    ss += (v0.x * v0.x + v0.y * v0.y) + (v0.z * v0.z + v0.w * v0.w) + (v1.x * v1.x + v1.y * v1.y) + (v1.z * v1.z + v1.w * v1.w);
                    const f32x4 h0 = v0 * gv[bj][0], h1 = v1 * gv[bj][1];
                    *(u32x4*)(H + ro + bj * HALF) = (u32x4){cvtpk(h0.x, h0.y), cvtpk(h0.z, h0.w), cvtpk(h1.x, h1.y), cvtpk(h1.z, h1.w)};
                }
                ss += __shfl_xor(ss, 16); ss += __shfl_xor(ss, 32); if (fq == 0) unsafeAtomicAdd(rowss + row, ss);
            }
    }
};

struct EpiQKV {
    static constexpr bool PERM = true; static constexpr int BMODE = 2; static constexpr int AMODE = 0;
    bf16_t* O; const float* bias; const float* rowss; const f32x4* rope; float* out;
    __device__ __forceinline__ void operator()(const f32x4 (&acc)[2][2][4][2], const Unit& u, int wr, int wc, int fr, int fq) const {
        const int hh = u.pn * 4 + wc, d0 = 8 * fq, colb = hh * HD + d0, row0 = u.pm * BM + wr * 64 + fr;
        f32x4 bv[2][2];
#pragma unroll
        for (int bj = 0; bj < 2; ++bj)
#pragma unroll
            for (int n = 0; n < 2; ++n) bv[bj][n] = *(const f32x4*)(bias + colb + 32 * bj + 4 * n);
#pragma unroll
        for (int ai = 0; ai < 2; ++ai)
#pragma unroll
            for (int m = 0; m < 4; ++m) { const int row = row0 + ai * HALF + m * 16;
                const float rs = 1.0f / sqrtf(rowss[row] * (1.0f / DM) + EPS);
                const bool samp = row >= MP; const int t = samp ? ((row - MP) & (TS - 1)) : (row & (TP - 1)), b = samp ? ((row - MP) >> 2) : (row >> 11);
                f32x4 x[2][2];
#pragma unroll
                for (int bj = 0; bj < 2; ++bj)
#pragma unroll
                    for (int n = 0; n < 2; ++n) x[bj][n] = acc[ai][bj][m][n] * rs + bv[bj][n];
                if (hh < NH + NKV) {
                    const f32x4* cs = rope + ((size_t)((row < MR) ? (samp ? TP + t : t) : 0) * 32 + d0) / 2;
#pragma unroll
                    for (int n = 0; n < 2; ++n) { const f32x4 c01 = cs[2 * n], c23 = cs[2 * n + 1]; const f32x4 a = x[0][n], bb = x[1][n];
                        x[0][n] = (f32x4){a.x * c01.x - bb.x * c01.y, a.y * c01.z - bb.y * c01.w, a.z * c23.x - bb.z * c23.y, a.w * c23.z - bb.w * c23.w};
                        x[1][n] = (f32x4){bb.x * c01.x + a.x * c01.y, bb.y * c01.z + a.y * c01.w, bb.z * c23.x + a.z * c23.y, bb.w * c23.z + a.w * c23.w}; }
                }
                bf16_t* op = O + (size_t)row * NQKV + colb;
#pragma unroll
                for (int bj = 0; bj < 2; ++bj) *(u32x4*)(op + 32 * bj) = (u32x4){cvtpk(x[bj][0].x, x[bj][0].y), cvtpk(x[bj][0].z, x[bj][0].w), cvtpk(x[bj][1].x, x[bj][1].y), cvtpk(x[bj][1].z, x[bj][1].w)};
                if (hh >= NH && row < MR) {
                    const int kvh = (hh - NH) & 7; const bool isv = hh >= NH + NKV; float* o = nullptr;
                    if (!samp) { if (t >= TP - WIN) o = out + (isv ? O_V_P : O_K_P) + (((size_t)b * WIN + (t - (TP - WIN))) * NKV + kvh) * HD + d0; }
                    else o = out + (isv ? O_V_S : O_K_S) + (((size_t)b * WIN + (WIN - TS + t)) * NKV + kvh) * HD + d0;
                    if (o) { *(f32x4*)o = x[0][0]; *(f32x4*)(o + 4) = x[0][1]; *(f32x4*)(o + 32) = x[1][0]; *(f32x4*)(o + 36) = x[1][1]; }
                }
            }
    }
};

template <class Epi, class Sched>
__device__ __forceinline__ void gemm_phase(LAS unsigned char* lds, const Gemm g, const Sched& S, const Epi& E, float* slab, int slabN, int slabPn0, unsigned* pubcnt = nullptr, int ibeg = 0, int iend = 1 << 30) {
    const int tid = threadIdx.x, wid = __builtin_amdgcn_readfirstlane(tid >> 6), lane = tid & 63, wr = wid >> 2, wc = wid & 3, fr = lane & 15, fq = lane >> 4;
    unsigned voffA[2], voffB[2];
#pragma unroll
    for (int i = 0; i < 2; ++i) { int R, C; stage_rc(tid * 16 + i * 8192, R, C);
        const int Rb = Epi::BMODE == 2 ? (64 * (R >> 5) + perm32(R & 31)) : Epi::BMODE != 0 ? ((R & ~31) + perm32(R & 31)) : R;
        const int Ra = Epi::AMODE != 0 ? ((R & ~63) + 4 * (R & 15) + ((R >> 4) & 3)) : R;
        voffA[i] = (unsigned)(Ra * g.lda + C) * 2u; voffB[i] = (unsigned)(Rb * g.ldb + C) * 2u; }
    const size_t kstep = (size_t)(BK * 2);
    const size_t hstepA = (size_t)HALF * g.lda * 2, hstepB = (size_t)(Epi::BMODE == 3 ? DFF : Epi::BMODE == 2 ? 32 : HALF) * g.ldb * 2;
    const unsigned ldsw = (unsigned)wid * 1024u;
    const int aoff = lds_byte(wr * 64 + fr, fq * 8), boff = lds_byte(wc * 32 + fr, fq * 8);
#define PG8_SA(b, h) (((b) * 2 + (h)) * HTB)
#define PG8_SB(b, h) ((4 + (b) * 2 + (h)) * HTB)
#define PG8_STAGE(bufoff, gbase, voff) do { _Pragma("unroll") for (int _i = 0; _i < 2; ++_i) \
        __builtin_amdgcn_global_load_lds((const unsigned*)((const char*)(gbase) + (voff)[_i]), (LAS unsigned*)(lds + (bufoff) + ldsw + _i * 8192), 16, 0, 0); } while (0)
#define PG8_LDA(dst, b, h) do { _Pragma("unroll") for (int m = 0; m < 4; ++m) _Pragma("unroll") for (int k = 0; k < 2; ++k) dst[m][k] = *(const LAS bf16x8*)(lds + PG8_SA(b, h) + aoff + m * 2048 + k * 1024); } while (0)
#define PG8_LDB(dst, b, h) do { _Pragma("unroll") for (int n = 0; n < 2; ++n) _Pragma("unroll") for (int k = 0; k < 2; ++k) dst[n][k] = *(const LAS bf16x8*)(lds + PG8_SB(b, h) + boff + n * 2048 + k * 1024); } while (0)
#define PG8_MMA(ai, bj, At, Bt) do { __builtin_amdgcn_s_setprio(1); _Pragma("unroll") for (int m = 0; m < 4; ++m) _Pragma("unroll") for (int n = 0; n < 2; ++n) _Pragma("unroll") for (int k = 0; k < 2; ++k) \
        acc[ai][bj][m][n] = __builtin_amdgcn_mfma_f32_16x16x32_bf16(Bt[n][k], At[m][k], acc[ai][bj][m][n], 0, 0, 0); __builtin_amdgcn_s_setprio(0); } while (0)
#define PG8_WAIT_V(n) asm volatile("s_waitcnt vmcnt(" #n ")" ::: "memory")
#define PG8_WAIT_L(n) asm volatile("s_waitcnt lgkmcnt(" #n ")" ::: "memory")
#define PG8_BAR __builtin_amdgcn_s_barrier()
#define PG8_SCHED __builtin_amdgcn_sched_barrier(0)
    Unit cur, nxt; int ui = ibeg;
    if (ibeg >= iend || !S.next(ibeg, cur)) return;
    f32x4 acc[2][2][4][2];
#pragma unroll
    for (int a = 0; a < 2; ++a)
#pragma unroll
        for (int b = 0; b < 2; ++b)
#pragma unroll
            for (int m = 0; m < 4; ++m)
#pragma unroll
                for (int n = 0; n < 2; ++n) acc[a][b][m][n] = (f32x4){0.f, 0.f, 0.f, 0.f};
    bf16x8 At[4][2], B0[2][2], B1[2][2];
    const char* cA = (const char*)g.A + cur.ao; const char* cB = (const char*)g.Bt + cur.bo;
    PG8_STAGE(PG8_SB(0, 0), cB, voffB); PG8_STAGE(PG8_SB(0, 1), cB + hstepB, voffB); PG8_STAGE(PG8_SA(0, 0), cA, voffA); PG8_STAGE(PG8_SA(0, 1), cA + hstepA, voffA);
    if (wr == 1) PG8_BAR;
    PG8_WAIT_V(2); PG8_BAR;
    PG8_STAGE(PG8_SB(1, 0), cB + kstep, voffB); PG8_STAGE(PG8_SA(1, 0), cA + kstep, voffA); PG8_STAGE(PG8_SB(1, 1), cB + hstepB + kstep, voffB);
    PG8_WAIT_V(6); PG8_BAR;
    for (;;) {
        if constexpr (Epi::AMODE != 0) E.stage(lds + WLDS_OFF + (ui & 1) * 3072, cur, wid, lane);
        const bool has_next = (ui + 1 < iend) && S.next(ui + 1, nxt);
        const char* nA = has_next ? (const char*)g.A + nxt.ao : cA; const char* nB = has_next ? (const char*)g.Bt + nxt.bo : cB;
        const int nt = cur.nkt; const bool full = cur.pm != 32;
        for (int t = 0; t < nt; t += 2) {
            const bool last = (t == nt - 2);
            const char* a1 = cA + (size_t)(t + 1) * kstep;
            const char* a2 = last ? nA : cA + (size_t)(t + 2) * kstep; const char* b2 = last ? nB : cB + (size_t)(t + 2) * kstep;
            const char* a3 = a2 + kstep; const char* b3 = b2 + kstep;
            PG8_LDB(B0, 0, 0); PG8_LDB(B1, 0, 1); PG8_SCHED; PG8_LDA(At, 0, 0); PG8_STAGE(PG8_SA(1, 1), a1 + hstepA, voffA);
            PG8_WAIT_V(8); PG8_WAIT_L(0); PG8_BAR; PG8_MMA(0, 0, At, B0); PG8_MMA(0, 1, At, B1); PG8_BAR; PG8_SCHED;
            PG8_LDA(At, 0, 1); PG8_STAGE(PG8_SB(0, 0), b2, voffB); PG8_STAGE(PG8_SB(0, 1), b2 + hstepB, voffB); PG8_STAGE(PG8_SA(0, 0), a2, voffA);
            PG8_WAIT_V(8); PG8_WAIT_L(0); PG8_BAR; if (full) { PG8_MMA(1, 0, At, B0); PG8_MMA(1, 1, At, B1); } PG8_BAR; PG8_SCHED;
            PG8_LDB(B0, 1, 0); PG8_LDB(B1, 1, 1); PG8_SCHED; PG8_LDA(At, 1, 0); PG8_STAGE(PG8_SA(0, 1), a2 + hstepA, voffA);
            PG8_WAIT_V(8); PG8_WAIT_L(0); PG8_BAR; PG8_MMA(0, 0, At, B0); PG8_MMA(0, 1, At, B1); PG8_BAR; PG8_SCHED;
            PG8_LDA(At, 1, 1); PG8_STAGE(PG8_SB(1, 0), b3, voffB); PG8_STAGE(PG8_SB(1, 1), b3 + hstepB, voffB); PG8_STAGE(PG8_SA(1, 0), a3, voffA);
            PG8_WAIT_V(8); PG8_WAIT_L(0); PG8_BAR; if (full) { PG8_MMA(1, 0, At, B0); PG8_MMA(1, 1, At, B1); } PG8_BAR; PG8_SCHED;
        }
        if (wr == 0) PG8_BAR;
        if (cur.mode) {
            static_assert(Epi::PERM, "slab store assumes the lane's 8 columns are contiguous");
            bf16_t* sp = (bf16_t*)slab + ((size_t)cur.sidx * 128 + wr * 64 + (Epi::AMODE != 0 ? 4 * fr : fr)) * slabN + (cur.pn - slabPn0) * BM + wc * 32 + 8 * fq;
#pragma unroll
            for (int m = 0; m < 4; ++m)
#pragma unroll
                for (int bj = 0; bj < 2; ++bj) { bf16_t* dp = sp + (size_t)(Epi::AMODE != 0 ? m : m * 16) * slabN + bj * HALF;
                    const f32x4 a0 = acc[0][bj][m][0], a1 = acc[0][bj][m][1];
                    const u32x4 pv = {cvtpk(a0.x, a0.y), cvtpk(a0.z, a0.w), cvtpk(a1.x, a1.y), cvtpk(a1.z, a1.w)};
                    if (pubcnt) asm volatile("global_store_dwordx4 %0, %1, off sc1" :: "v"(dp), "v"(pv) : "memory");
                    else *(u32x4*)dp = pv; }
            if (pubcnt) { PG8_WAIT_V(0); PG8_BAR; if (tid == 0) __hip_atomic_fetch_add(pubcnt, 1u, __ATOMIC_RELAXED, __HIP_MEMORY_SCOPE_AGENT); }
        } else { if constexpr (Epi::AMODE != 0) E(acc, cur, wr, wc, fr, fq, (const LAS float*)(lds + WLDS_OFF + (ui & 1) * 3072)); else E(acc, cur, wr, wc, fr, fq); }
        if (!has_next) break;
#pragma unroll
        for (int a = 0; a < 2; ++a)
#pragma unroll
            for (int b = 0; b < 2; ++b)
#pragma unroll
                for (int m = 0; m < 4; ++m)
#pragma unroll
                    for (int n = 0; n < 2; ++n) acc[a][b][m][n] = (f32x4){0.f, 0.f, 0.f, 0.f};
        cur = nxt; cA = nA; cB = nB; ++ui;
        if (wr == 1) PG8_BAR;
    }
    PG8_WAIT_V(0);
    PG8_BAR;
#undef PG8_SA
#undef PG8_SB
#undef PG8_STAGE
#undef PG8_LDA
#undef PG8_LDB
#undef PG8_MMA
#undef PG8_WAIT_V
#undef PG8_WAIT_L
#undef PG8_BAR
#undef PG8_SCHED
}
}

#define XB_TMO      128
#define XB_XCNT(j)  (256  + 64 * (j))
#define XB_XSUB(j)  (1280 + 64 * (j))
#define XB_XGEN(j)  (2304 + 64 * (j))
#define XB_TOP      3328
#define XB_TOPGEN   3392
#define XCD_BAR_WORDS 3456
#define XB_SPIN_CAP (1u << 18)
__device__ __forceinline__ unsigned xb_ld(unsigned* p)              { return __hip_atomic_load(p, __ATOMIC_RELAXED, __HIP_MEMORY_SCOPE_AGENT); }
__device__ __forceinline__ unsigned xb_add(unsigned* p, unsigned v) { return __hip_atomic_fetch_add(p, v, __ATOMIC_RELAXED, __HIP_MEMORY_SCOPE_AGENT); }
__device__ __forceinline__ unsigned xb_xcc_id() { return (unsigned)__builtin_amdgcn_s_getreg((3 << 11) | 20) & 0xFu; }
#define XB_SPIN(cond, bar) do { unsigned _sp = 0; while (cond) { __builtin_amdgcn_s_sleep(1); \
    if ((++_sp & 255u) == 0u) { if (xb_ld(&(bar)[XB_TMO])) break; if (_sp > XB_SPIN_CAP) { atomicAdd(&(bar)[XB_TMO], 1u); break; } } } } while (0)
struct XcdBarrier { unsigned* bar; unsigned x; volatile LAS unsigned* st; };
__device__ __forceinline__ XcdBarrier xcd_barrier_post(unsigned* bar, volatile LAS unsigned* st) {
    XcdBarrier b; b.bar = bar; b.x = xb_xcc_id(); b.st = st;
    if (threadIdx.x == 0) (void)xb_add(&bar[XB_XCNT(b.x)], 1u);
    return b;
}
__device__ __forceinline__ void xcd_barrier_complete(unsigned* bar, unsigned x, unsigned& nloc, unsigned& nx) {
    const unsigned G = gridDim.x * gridDim.y * gridDim.z;
    unsigned sum, cnt, mine, sp = 0u;
    for (;;) {
        sum = 0u; cnt = 0u; mine = 0u;
#pragma unroll
        for (unsigned j = 0; j < 16; ++j) { const unsigned c = xb_ld(&bar[XB_XCNT(j)]); sum += c; cnt += (c > 0u) ? 1u : 0u; mine = (j == x) ? c : mine; }
        if (sum == G) break;
        __builtin_amdgcn_s_sleep(1);
        if ((++sp & 255u) == 0u) { if (xb_ld(&bar[XB_TMO])) break; if (sp > XB_SPIN_CAP) { atomicAdd(&bar[XB_TMO], 1u); break; } }
    }
    nloc = mine > 0u ? mine : 1u; nx = cnt > 0u ? cnt : 1u;
}
__device__ __forceinline__ void xcd_barrier(const XcdBarrier& b) {
    asm volatile("s_waitcnt vmcnt(0)" ::: "memory");
    __syncthreads();
    if (threadIdx.x == 0) {
        unsigned* bar = b.bar;
        __builtin_amdgcn_s_waitcnt(0);
        unsigned nloc = b.st[0], nx = b.st[1];
        if (nloc == 0u) { xcd_barrier_complete(bar, b.x, nloc, nx); b.st[0] = nloc; b.st[1] = nx; }
        const unsigned old = xb_add(&bar[XB_XSUB(b.x)], 1u);
        const unsigned gen = old / nloc;
        if (old + 1u == (gen + 1u) * nloc) {
            __builtin_amdgcn_fence(__ATOMIC_RELEASE, "agent");
            asm volatile("s_waitcnt vmcnt(0)" ::: "memory");
            const unsigned og = xb_add(&bar[XB_TOP], 1u);
            const unsigned tg = og / nx;
            if (og + 1u == (tg + 1u) * nx) xb_add(&bar[XB_TOPGEN], 1u);
            else XB_SPIN(xb_ld(&bar[XB_TOPGEN]) == tg, bar);
            __builtin_amdgcn_fence(__ATOMIC_ACQUIRE, "agent");
            xb_add(&bar[XB_XGEN(b.x)], 1u);
            asm volatile("s_waitcnt vmcnt(0)" ::: "memory");
        } else {
            XB_SPIN(xb_ld(&bar[XB_XGEN(b.x)]) == gen, bar);
            __builtin_amdgcn_fence(__ATOMIC_ACQUIRE, "agent");
            asm volatile("s_waitcnt vmcnt(0)" ::: "memory");
        }
    }
    __syncthreads();
}

struct Params;
__device__ __forceinline__ bool bg_step(const Params& p, LAS unsigned char* lds, volatile LAS unsigned* st);
__device__ __forceinline__ void xcd_barrier_bg(const XcdBarrier& b, const Params& p, LAS unsigned char* lds) {
    volatile LAS unsigned* st = b.st;
    asm volatile("s_waitcnt vmcnt(0)" ::: "memory");
    __syncthreads();
    unsigned* bar = b.bar;
    if (threadIdx.x == 0) {
        __builtin_amdgcn_s_waitcnt(0);
        unsigned nloc = st[0], nx = st[1];
        if (nloc == 0u) { xcd_barrier_complete(bar, b.x, nloc, nx); st[0] = nloc; st[1] = nx; }
        const unsigned old = xb_add(&bar[XB_XSUB(b.x)], 1u);
        const unsigned gen = old / nloc;
        const bool leader = old + 1u == (gen + 1u) * nloc;
        st[2] = leader ? 1u : 0u; st[3] = gen;
        if (leader) {
            __builtin_amdgcn_fence(__ATOMIC_RELEASE, "agent");
            asm volatile("s_waitcnt vmcnt(0)" ::: "memory");
            const unsigned og = xb_add(&bar[XB_TOP], 1u);
            const unsigned tg = og / nx;
            if (og + 1u == (tg + 1u) * nx) xb_add(&bar[XB_TOPGEN], 1u);
            else XB_SPIN(xb_ld(&bar[XB_TOPGEN]) == tg, bar);
            __builtin_amdgcn_fence(__ATOMIC_ACQUIRE, "agent");
            xb_add(&bar[XB_XGEN(b.x)], 1u);
            asm volatile("s_waitcnt vmcnt(0)" ::: "memory");
        }
    }
    __syncthreads();
    if (st[2] == 0u) {
        const unsigned gen = st[3];
        __syncthreads();
        for (;;) {
            if (threadIdx.x == 0) st[4] = (xb_ld(&bar[XB_XGEN(b.x)]) != gen) ? 1u : 0u;
            __syncthreads();
            const bool rel = st[4] != 0u;
            __syncthreads();
            if (rel) break;
            if (!bg_step(p, lds, st)) {
                if (threadIdx.x == 0) XB_SPIN(xb_ld(&bar[XB_XGEN(b.x)]) == gen, bar);
                break; }
        }
        if (threadIdx.x == 0) {
            asm volatile("s_waitcnt vmcnt(0)" ::: "memory");
            __builtin_amdgcn_fence(__ATOMIC_ACQUIRE, "agent");
            asm volatile("s_waitcnt vmcnt(0)" ::: "memory");
        }
    }
    __syncthreads();
}

struct Params { const float* in[22]; float* out; unsigned char* ws; int ph_lo, ph_hi; };
enum { I_XP = 0, I_XS, I_SCONV, I_SPOOL, I_CK, I_CV, I_SFFN, I_NMIX, I_WIN, I_CONVA, I_WPOOL, I_PSCALE, I_WOUT, I_WQKV, I_BQKV, I_SINKS, I_WO, I_NFFN, I_WUP, I_CONVF, I_WDN, I_NFIN };

__device__ __forceinline__ void slab_sum8(const float* slab, int N, int s, int srow, int col, float (&v)[8]) {
    const float* sp = slab + (size_t)srow * N + col;
    f32x4 a = {0.f, 0.f, 0.f, 0.f}, b = {0.f, 0.f, 0.f, 0.f};
#pragma unroll 4
    for (int q = 0; q < s; ++q) { a += *(const f32x4*)sp; b += *(const f32x4*)(sp + 4); sp += (size_t)128 * N; }
    v[0] = a.x; v[1] = a.y; v[2] = a.z; v[3] = a.w; v[4] = b.x; v[5] = b.y; v[6] = b.z; v[7] = b.w;
}
constexpr int S_IN = 8, S_RES = 16, S_UP = 11, UP_PNSPLIT = 64;
__device__ __forceinline__ void ld_proj8(const bf16_t* PROJ, const float*, int row, int col, float (&v)[8]) { load8(PROJ + (size_t)row * NIN + col, v); }
__device__ __forceinline__ void ld_u8(const bf16_t* U, const float*, const float*, int row, int col, float (&v)[8]) { load8(U + (size_t)row * NUP + col, v); }

constexpr int TSCR = 64 * 65 * 4;
__device__ __forceinline__ void p0_transpose_item(const float* W, int K, int N, bf16_t* WT, LAS float* scr, int item, int lane) {
    const int nblk = N / 64, kb = item / nblk, nb = item % nblk, k0 = 64 * kb, n0 = 64 * nb;
    const int lr = lane >> 4, lc = (lane & 15) * 4;
    f32x4 tv[16];
#pragma unroll
    for (int i = 0; i < 16; ++i) tv[i] = __builtin_nontemporal_load((const f32x4*)(W + (size_t)(k0 + 4 * i + lr) * N + n0 + lc));
#pragma unroll
    for (int i = 0; i < 16; ++i) { LAS float* d = scr + (4 * i + lr) * 65 + lc; d[0] = tv[i].x; d[1] = tv[i].y; d[2] = tv[i].z; d[3] = tv[i].w; }
    asm volatile("s_waitcnt lgkmcnt(0)" ::: "memory");
    const int c = lane & 7, nl = lane >> 3;
#pragma unroll
    for (int j = 0; j < 8; ++j) { const int n = nl + 8 * j; const LAS float* s = scr + (8 * c) * 65 + n;
        u32x4 o; o.x = cvtpk(s[0 * 65], s[1 * 65]); o.y = cvtpk(s[2 * 65], s[3 * 65]); o.z = cvtpk(s[4 * 65], s[5 * 65]); o.w = cvtpk(s[6 * 65], s[7 * 65]);
        __builtin_nontemporal_store(o, (u32x4*)(WT + (size_t)(n0 + n) * K + k0 + 8 * c)); }
    asm volatile("s_waitcnt lgkmcnt(0)" ::: "memory");
}
constexpr int CI_IN = (DM / 64) * (NIN / 64), CI_PL = (PGRP / 64) * (PGRP / 64), CI_SQ = (DM / 64) * (DM / 64), CI_QKV = (DM / 64) * (NQKV / 64), CI_UP = (DM / 64) * (NUP / 64), CI_DN = (DFF / 64) * (DM / 64);
constexpr int CJ0 = 0, CJ1 = CI_IN, CJ2 = CJ1 + 4 * CI_PL + CI_SQ + CI_UP, CJ3 = CJ2 + CI_DN, CJ4 = CJ3 + CI_QKV + CI_SQ + CI_UP + CI_DN;
__device__ __forceinline__ void convert_one(const Params& p, LAS float* scr, int it, int lane) {
    unsigned char* ws = p.ws; int r = it;
    if (r < CI_IN) { p0_transpose_item(p.in[I_WIN], DM, NIN, (bf16_t*)(ws + WS_WIN), scr, r, lane); return; } r -= CI_IN;
    if (r < 4 * CI_PL) { const int g = r / CI_PL; p0_transpose_item(p.in[I_WPOOL] + (size_t)g * PGRP * PGRP, PGRP, PGRP, (bf16_t*)(ws + WS_WPOOL) + (size_t)g * PGRP * PGRP, scr, r % CI_PL, lane); return; } r -= 4 * CI_PL;
    if (r < CI_SQ) { p0_transpose_item(p.in[I_WOUT], DM, DM, (bf16_t*)(ws + WS_WOUT), scr, r, lane); return; } r -= CI_SQ;
    if (r < CI_UP) { p0_transpose_item(p.in[I_WUP], DM, NUP, (bf16_t*)(ws + WS_WUP), scr, r, lane); return; } r -= CI_UP;
    if (r < CI_DN) { p0_transpose_item(p.in[I_WDN], DFF, DM, (bf16_t*)(ws + WS_WDN), scr, r, lane); return; } r -= CI_DN;
    if (r < CI_QKV) { p0_transpose_item(p.in[I_WQKV], DM, NQKV, (bf16_t*)(ws + WS_WQKV), scr, r, lane); return; } r -= CI_QKV;
    if (r < CI_SQ) { p0_transpose_item(p.in[I_WO], DM, DM, (bf16_t*)(ws + WS_WO), scr, r, lane); return; } r -= CI_SQ;
    if (r < CI_UP) { p0_transpose_item(p.in[I_WUP] + (size_t)DM * NUP, DM, NUP, (bf16_t*)(ws + WS_WUP) + WUP_STRIDE, scr, r, lane); return; } r -= CI_UP;
    p0_transpose_item(p.in[I_WDN] + (size_t)DFF * DM, DFF, DM, (bf16_t*)(ws + WS_WDN) + WDN_STRIDE, scr, r, lane);
}
__device__ __forceinline__ void convert_items(const Params& p, LAS unsigned char* lds, int G, int a, int b) {
    const int tid = threadIdx.x, lane = tid & 63, wave = __builtin_amdgcn_readfirstlane(tid >> 6);
    LAS float* scr = (LAS float*)(lds + wave * TSCR);
    const int gw = blockIdx.x * NWAVES + wave, NGW = G * NWAVES;
    for (int it = a + gw; it < b; it += NGW) convert_one(p, scr, it, lane);
    asm volatile("s_waitcnt vmcnt(0)" ::: "memory"); __syncthreads();
}
constexpr int BQ0 = CI_IN + 4 * CI_PL + CI_SQ;
constexpr int BQ_UP0 = BQ0 + CI_UP, BQ_DN0 = BQ_UP0 + CI_DN, BQ_QKV = BQ_DN0 + CI_QKV, BQ_O = BQ_QKV + CI_SQ, BQ_UP1 = BQ_O + CI_UP, BQ_DN1 = BQ_UP1 + CI_DN;
static_assert(BQ_DN1 == CJ4, "queue covers every remaining item");
constexpr int CW_BGQ = 12288;
__device__ __forceinline__ bool bg_step(const Params& p, LAS unsigned char* lds, volatile LAS unsigned* st) {
    unsigned* ctr = (unsigned*)(p.ws + WS_CTL) + CW_BGQ;
    if (threadIdx.x == 0) st[12] = __hip_atomic_fetch_add(ctr, 1u, __ATOMIC_RELAXED, __HIP_MEMORY_SCOPE_AGENT);
    __syncthreads();
    const int it0 = BQ0 + 8 * (int)st[12];
    __syncthreads();
    if (it0 >= CJ4) return false;
    const int lane = threadIdx.x & 63, wave = __builtin_amdgcn_readfirstlane(threadIdx.x >> 6);
    if (it0 + wave < CJ4) convert_one(p, (LAS float*)(lds + wave * TSCR), it0 + wave, lane);
    return true;
}
__device__ __forceinline__ void bg_drain(const Params& p, LAS unsigned char* lds, volatile LAS unsigned* st, int upto) {
    unsigned* ctr = (unsigned*)(p.ws + WS_CTL) + CW_BGQ;
    for (;;) {
        if (threadIdx.x == 0) st[13] = __hip_atomic_load(ctr, __ATOMIC_RELAXED, __HIP_MEMORY_SCOPE_AGENT);
        __syncthreads();
        const bool done = BQ0 + 8 * (int)st[13] >= upto;
        __syncthreads();
        if (done || !bg_step(p, lds, st)) break;
    }
}
__device__ __forceinline__ void prologue_phase(const Params& p, LAS unsigned char* lds, int G) {
    const int tid = threadIdx.x;
    unsigned char* ws = p.ws;
    convert_items(p, lds, G, CJ0, BG_CONV ? BQ0 : CJ4);
    for (int i = blockIdx.x * NTHR + tid; i < 4 * MPAD; i += G * NTHR) ((float*)(ws + WS_ROWSS))[i] = 0.f;
    for (int i = blockIdx.x * NTHR + tid; i < 4 * DM; i += G * NTHR) { const int k = i / DM, c = i - k * DM;
        ((float*)(ws + WS_IGAIN))[i] = 1.0f / (k == 0 ? p.in[I_NFFN][c] : k == 1 ? p.in[I_NMIX][DM + c] : k == 2 ? p.in[I_NFFN][DM + c] : p.in[I_NMIX][c]); }
    f32x2* rope = (f32x2*)(ws + WS_ROPE);
    for (int i = blockIdx.x * NTHR + tid; i < (TP + TS) * 32; i += G * NTHR) {
        const int pi = i >> 5, d = i & 31; const int pos = pi < TP ? pi : PAST + (pi - TP);
        const float inv = (float)exp2(-(double)d * (13.287712379549449 / 32.0));
        const float ang = (float)pos * inv;
        const double a = (double)ang, kq = __builtin_rint(a * 0.63661977236758134), rr = a - kq * 1.5707963267948966, r2 = rr * rr;
        const double sn = rr * (1.0 + r2 * (-1.0 / 6 + r2 * (1.0 / 120 + r2 * (-1.0 / 5040 + r2 * (1.0 / 362880 + r2 * (-1.0 / 39916800 + r2 * (1.0 / 6227020800.0)))))));
        const double cs = 1.0 + r2 * (-0.5 + r2 * (1.0 / 24 + r2 * (-1.0 / 720 + r2 * (1.0 / 40320 + r2 * (-1.0 / 3628800 + r2 * (1.0 / 479001600.0 + r2 * (-1.0 / 87178291200.0)))))));
        const int qd = (int)((long long)kq & 3);
        const double c = qd == 0 ? cs : qd == 1 ? -sn : qd == 2 ? -cs : sn, s = qd == 0 ? sn : qd == 1 ? cs : qd == 2 ? -sn : -cs;
        rope[i] = (f32x2){(float)c, (float)s};
    }
}

template <int MODE> __device__ __forceinline__ void norm_phase(const Params& p, const float* gain, int G) {
    const int tid = threadIdx.x, lane = tid & 63, wave = __builtin_amdgcn_readfirstlane(tid >> 6);
    const int gw = blockIdx.x * NWAVES + wave, NGW = G * NWAVES;
    float* X = (float*)(p.ws + WS_X); bf16_t* H = (bf16_t*)(p.ws + WS_H); const float* slab = (const float*)(p.ws + WS_SLAB);
    const int nlist = MP + ((MODE == 2) ? 0 : (MPAD - MR));
    for (int i = gw; i < nlist + MS * 16; i += NGW) {
        int r;
        if (i < MP) r = i; else if (i < nlist) r = MR + (i - MP); else { if ((i - nlist) & 15) continue; r = MP + ((i - nlist) >> 4); }
        if (r >= MR) {
            u32x2* o = (u32x2*)(H + (size_t)r * DM) + lane;
#pragma unroll
            for (int j = 0; j < 16; ++j) o[64 * j] = (u32x2){0u, 0u};
            continue;
        }
        if (MODE == 2 && r < MP) {
            const float rs = 1.0f / sqrtf(((const float*)(p.ws + WS_ROWSS))[3 * MPAD + r] * (1.0f / DM) + EPS);
            const u32x4* hr = (const u32x4*)(H + (size_t)r * DM) + lane; f32x4* o = (f32x4*)(p.out + O_Y + (size_t)r * DM) + 2 * lane;
            u32x4 w[8];
#pragma unroll
            for (int j = 0; j < 8; ++j) w[j] = hr[64 * j];
#pragma unroll
            for (int j = 0; j < 8; ++j) { __builtin_nontemporal_store((f32x4){bflo(w[j].x), bfhi(w[j].x), bflo(w[j].y), bfhi(w[j].y)} * rs, o + 128 * j); __builtin_nontemporal_store((f32x4){bflo(w[j].z), bfhi(w[j].z), bflo(w[j].w), bfhi(w[j].w)} * rs, o + 128 * j + 1); }
            continue;
        }
        const float* src = (MODE == 0) ? (r < MP ? p.in[I_XP] + (size_t)r * DM : p.in[I_XS] + (size_t)(r - MP) * DM) : X + (size_t)r * DM;
        const f32x4* xr = (const f32x4*)src + lane;
        f32x4 v[16]; float ss = 0.f;
#pragma unroll
        for (int j = 0; j < 16; ++j) v[j] = xr[64 * j];
        if (r >= MP) {
            f32x4* xw = (f32x4*)(X + (size_t)r * DM) + lane;
            if (MODE == 1) {
                const f32x4* sp = (const f32x4*)(slab + (size_t)(r - MP) * DM) + lane;
                for (int q = 0; q < S_RES; ++q) {
#pragma unroll
                    for (int j = 0; j < 16; ++j) v[j] += sp[64 * j];
                    sp += (size_t)128 * DM / 4; } }
            if (MODE != 2) {
#pragma unroll
                for (int j = 0; j < 16; ++j) xw[64 * j] = v[j]; }
        }
#pragma unroll
        for (int j = 0; j < 16; ++j) ss += (v[j].x * v[j].x + v[j].y * v[j].y) + (v[j].z * v[j].z + v[j].w * v[j].w);
        const float sst = wave_sum(ss);
        if (MODE == 0 && lane == 0) ((float*)(p.ws + WS_ROWSS))[4 * MPAD + r] = sst;
        const float rs = 1.0f / sqrtf(sst * (1.0f / DM) + EPS);
        const f32x4* gr = (const f32x4*)gain + lane;
        if (MODE == 2) { f32x4* o = (f32x4*)(p.out + O_Y + (size_t)r * DM) + lane;
#pragma unroll
            for (int j = 0; j < 16; ++j) { const f32x4 g4 = gr[64 * j]; o[64 * j] = v[j] * rs * g4; }
        } else { u32x2* o = (u32x2*)(H + (size_t)r * DM) + lane;
#pragma unroll
            for (int j = 0; j < 16; ++j) { const f32x4 g4 = gr[64 * j]; const f32x4 y = v[j] * rs * g4; o[64 * j] = (u32x2){cvtpk(y.x, y.y), cvtpk(y.z, y.w)}; }
        }
    }
}

template <int R, bool SAMP> __device__ __forceinline__ void conv_task(const Params& p, int row0, int b, int t0, int c0) {
    const bf16_t* PROJ = (const bf16_t*)(p.ws + WS_PROJ); bf16_t* CAT = (bf16_t*)(p.ws + WS_CAT); const float* slab = (const float*)(p.ws + WS_SLAB);
    const float* cw = p.in[I_CONVA]; float* out = p.out;
    float g[R + 2][8], gb[R][8], w[3][8];
#pragma unroll
    for (int k = 0; k < 3; ++k) loadf8(cw + (size_t)k * DA + c0, w[k]);
#pragma unroll
    for (int i = 0; i < R + 2; ++i) {
        const int tt = t0 + i - 2;
        if (tt >= 0) { float gc[8], xa[8]; ld_proj8(PROJ, slab, row0 + i - 2, DA + c0, gc); ld_proj8(PROJ, slab, row0 + i - 2, 2 * DA + c0, xa);
#pragma unroll
            for (int e = 0; e < 8; ++e) g[i][e] = gc[e] * xa[e]; }
        else if (SAMP) loadf8(p.in[I_SCONV] + ((size_t)b * 2 + (2 + tt)) * DA + c0, g[i]);
        else {
#pragma unroll
            for (int e = 0; e < 8; ++e) g[i][e] = 0.f; }
    }
#pragma unroll
    for (int i = 0; i < R; ++i) ld_proj8(PROJ, slab, row0 + i, c0, gb[i]);
#pragma unroll
    for (int i = 0; i < R; ++i) {
        float a[8];
#pragma unroll
        for (int e = 0; e < 8; ++e) a[e] = (g[i][e] * w[0][e] + g[i + 1][e] * w[1][e] + g[i + 2][e] * w[2][e]) * gb[i][e];
        store8(CAT + (size_t)(row0 + i) * DM + c0, a);
        const int t = t0 + i;
        if (!SAMP) { if (t >= TP - 2) storef8(out + O_CA_P + ((size_t)b * 2 + (t - (TP - 2))) * DA + c0, g[i + 2]); }
        else { if (t >= 2) storef8(out + O_CA_S + ((size_t)b * 2 + (t - 2)) * DA + c0, g[i + 2]); }
    }
}
template <int R, int W, bool SAMP> __device__ __forceinline__ void pool_task(const Params& p, int row0, int b, int t0, int c0) {
    const bf16_t* PROJ = (const bf16_t*)(p.ws + WS_PROJ); bf16_t* POOLED = (bf16_t*)(p.ws + WS_POOLED); const float* slab = (const float*)(p.ws + WS_SLAB);
    const float* spool = p.in[I_SPOOL]; float* out = p.out;
    float z[R + W - 1][8];
#pragma unroll
    for (int i = 0; i < R + W - 1; ++i) {
        const int tt = t0 + i - (W - 1);
        if (tt >= 0) ld_proj8(PROJ, slab, row0 + i - (W - 1), 3 * DA + c0, z[i]);
        else if (SAMP) loadf8(spool + ((size_t)b * 15 + (15 + tt)) * DB + c0, z[i]);
        else {
#pragma unroll
            for (int e = 0; e < 8; ++e) z[i][e] = 0.f; }
    }
#pragma unroll
    for (int i = 0; i < R; ++i) {
        float s[8];
#pragma unroll
        for (int e = 0; e < 8; ++e) s[e] = z[i][e];
#pragma unroll
        for (int j = 1; j < W; ++j)
#pragma unroll
            for (int e = 0; e < 8; ++e) s[e] += z[i + j][e];
        const int t = t0 + i; const float cnt = SAMP ? (float)W : (float)((t + 1) < W ? (t + 1) : W);
#pragma unroll
        for (int e = 0; e < 8; ++e) s[e] = s[e] / cnt - z[i + W - 1][e];
        store8(POOLED + (size_t)(row0 + i) * DB + c0, s);
        if (!SAMP) { if (t >= TP - 15) storef8(out + O_PL_P + ((size_t)b * 15 + (t - (TP - 15))) * DB + c0, z[i + W - 1]); }
        else storef8(out + O_PL_S + ((size_t)b * 15 + 11 + t) * DB + c0, z[i + W - 1]);
    }
    if (SAMP) { float v[8]; for (int k = 0; k < 11; ++k) { loadf8(spool + ((size_t)b * 15 + k + 4) * DB + c0, v); storef8(out + O_PL_S + ((size_t)b * 15 + k) * DB + c0, v); } }
}
template <int R, bool SAMP> __device__ __forceinline__ void pool_task_g(const Params& p, int row0, int b, int t0, int c0) {
    const int gi = c0 >> 9;
    if (gi == 0) pool_task<R, 2, SAMP>(p, row0, b, t0, c0); else if (gi == 1) pool_task<R, 4, SAMP>(p, row0, b, t0, c0);
    else if (gi == 2) pool_task<R, 8, SAMP>(p, row0, b, t0, c0);
    else { if (R == 8) { pool_task<4, 16, SAMP>(p, row0, b, t0, c0); pool_task<4, 16, SAMP>(p, row0 + 4, b, t0 + 4, c0); } else pool_task<R, 16, SAMP>(p, row0, b, t0, c0); }
}
__device__ __forceinline__ void mixer_phase(const Params& p, int G) {
    bf16_t* CAT = (bf16_t*)(p.ws + WS_CAT); bf16_t* POOLED = (bf16_t*)(p.ws + WS_POOLED);
    constexpr int NT_P = (MP / 8) * 512, NT_S = NBS * 512, NT_Z = (MPAD - MR) * 512;
    for (int it = blockIdx.x * NTHR + threadIdx.x; it < NT_P + NT_S + NT_Z; it += G * NTHR) {
        if (it < NT_P) { const int rg = it >> 9, q = it & 511, row0 = rg * 8, b = row0 >> 11, t0 = row0 & (TP - 1);
            if (q < 256) conv_task<8, false>(p, row0, b, t0, 8 * q); else pool_task_g<8, false>(p, row0, b, t0, 8 * (q - 256)); }
        else if (it < NT_P + NT_S) { const int j = it - NT_P, b = j >> 9, q = j & 511, row0 = MP + b * TS;
            if (q < 256) conv_task<TS, true>(p, row0, b, 0, 8 * q); else pool_task_g<TS, true>(p, row0, b, 0, 8 * (q - 256)); }
        else { const int j = it - NT_P - NT_S, r = MR + (j >> 9), q = j & 511; const u32x4 z = {0u, 0u, 0u, 0u};
            if (q < 256) *(u32x4*)(CAT + (size_t)r * DM + 8 * q) = z; else *(u32x4*)(POOLED + (size_t)r * DB + 8 * (q - 256)) = z; }
    }
}

template <int R, bool SAMP> __device__ __forceinline__ void ffn_task(const Params& p, int layer, const float* rowss, int row0, int b, int t0, int c0) {
    const bf16_t* U = (const bf16_t*)(p.ws + WS_U); bf16_t* ACT = (bf16_t*)(p.ws + WS_ACT); const float* slab = (const float*)(p.ws + WS_SLAB);
    const float* cw = p.in[I_CONVF] + (size_t)layer * 3 * NUP; float* out = p.out;
    float g[R + 2][8], u[R + 2][8], wg[3][8], wu[3][8];
#pragma unroll
    for (int k = 0; k < 3; ++k) { loadf8(cw + (size_t)k * NUP + c0, wg[k]); loadf8(cw + (size_t)k * NUP + DFF + c0, wu[k]); }
#pragma unroll
    for (int i = 0; i < R + 2; ++i) {
        const int tt = t0 + i - 2;
        if (SAMP) {
            if (tt >= 0) { load8(U + (size_t)(row0 + i - 2) * NUP + c0, g[i]); ld_u8(U, slab, rowss, row0 + i - 2, DFF + c0, u[i]); }
            else { const float* sf = p.in[I_SFFN] + (((size_t)layer * NBS + b) * 2 + (2 + tt)) * NUP + c0; loadf8(sf, g[i]); loadf8(sf + DFF, u[i]); }
        } else {
            if (tt >= 0) { load8(U + (size_t)(row0 + i - 2) * NUP + c0, g[i]); load8(U + (size_t)(row0 + i - 2) * NUP + DFF + c0, u[i]); }
            else {
#pragma unroll
                for (int e = 0; e < 8; ++e) { g[i][e] = 0.f; u[i][e] = 0.f; } }
        }
    }
#pragma unroll
    for (int i = 0; i < R; ++i) {
        float a[8];
#pragma unroll
        for (int e = 0; e < 8; ++e) {
            const float cg = g[i][e] * wg[0][e] + g[i + 1][e] * wg[1][e] + g[i + 2][e] * wg[2][e];
            const float cu = u[i][e] * wu[0][e] + u[i + 1][e] * wu[1][e] + u[i + 2][e] * wu[2][e];
            a[e] = cg / (1.0f + __expf(-cg)) * cu; }
        store8(ACT + (size_t)(row0 + i) * DFF + c0, a);
        const int t = t0 + i;
        if (!SAMP) { if (t >= TP - 2) { float* o = out + O_F_P + (((size_t)layer * NBP + b) * 2 + (t - (TP - 2))) * NUP + c0; storef8(o, g[i + 2]); storef8(o + DFF, u[i + 2]); } }
        else { if (t >= 2) { float* o = out + O_F_S + (((size_t)layer * NBS + b) * 2 + (t - 2)) * NUP + c0; storef8(o, g[i + 2]); storef8(o + DFF, u[i + 2]); } }
    }
}
__device__ __forceinline__ void ffnconv_phase(const Params& p, int layer, const float* rowss, int G) {
    constexpr int NCH = DFF / 8;
    constexpr int NT_P = (MP / 8) * NCH, NT_S = NBS * NCH, NT_Z = (MPAD - MR) * NCH;
    bf16_t* ACT = (bf16_t*)(p.ws + WS_ACT);
    for (int it = blockIdx.x * NTHR + threadIdx.x; it < NT_P + NT_S + NT_Z; it += G * NTHR) {
        if (it < NT_P) { const int rg = it / NCH, q = it - rg * NCH, row0 = rg * 8; ffn_task<8, false>(p, layer, rowss, row0, row0 >> 11, row0 & (TP - 1), 8 * q); }
        else if (it < NT_P + NT_S) { const int j = it - NT_P, b = j / NCH, q = j - b * NCH; ffn_task<TS, true>(p, layer, rowss, MP + b * TS, b, 0, 8 * q); }
        else { const int j = it - NT_P - NT_S, r = j / NCH, q = j - r * NCH; *(u32x4*)(ACT + (size_t)(MR + r) * DFF + 8 * q) = (u32x4){0u, 0u, 0u, 0u}; }
    }
}

__device__ __forceinline__ void ffnfix_phase(const Params& p, int layer, int G) {
    constexpr int NCH = DFF / 8;
    constexpr int NT_A = 32 * 4 * NCH, NT_S = NBS * NCH, NT_Z = (MPAD - MR) * NCH;
    bf16_t* ACT = (bf16_t*)(p.ws + WS_ACT); const bf16_t* halo = (const bf16_t*)(p.ws + WS_HALO);
    const float* cw = p.in[I_CONVF] + (size_t)layer * 3 * NUP;
    for (int it = blockIdx.x * NTHR + threadIdx.x; it < NT_A + NT_S + NT_Z; it += G * NTHR) {
        if (it < NT_A) {
            const int pb = it / NCH, q = it - pb * NCH, pm = pb >> 2, blk = pb & 3, c0 = 8 * q;
            const bf16_t* hc = halo + ((size_t)(pm * 4 + blk) * 4) * NUP + c0;
            const bool hasprev = blk > 0 || (pm & 7) != 0;
            const bf16_t* hp = halo + ((size_t)(blk > 0 ? pm * 4 + blk - 1 : (pm - 1) * 4 + 3) * 4 + 2) * NUP + c0;
            float g[4][8], u[4][8], wg[3][8], wu[3][8];
#pragma unroll
            for (int k = 0; k < 3; ++k) { loadf8(cw + (size_t)k * NUP + c0, wg[k]); loadf8(cw + (size_t)k * NUP + DFF + c0, wu[k]); }
            if (hasprev) { load8(hp, g[0]); load8(hp + DFF, u[0]); load8(hp + NUP, g[1]); load8(hp + NUP + DFF, u[1]); }
            else {
#pragma unroll
                for (int e = 0; e < 8; ++e) { g[0][e] = 0.f; u[0][e] = 0.f; g[1][e] = 0.f; u[1][e] = 0.f; } }
            load8(hc, g[2]); load8(hc + DFF, u[2]); load8(hc + NUP, g[3]); load8(hc + NUP + DFF, u[3]);
#pragma unroll
            for (int j = 0; j < 2; ++j) { float a[8];
#pragma unroll
                for (int e = 0; e < 8; ++e) { const float cg = g[j][e] * wg[0][e] + g[j + 1][e] * wg[1][e] + g[j + 2][e] * wg[2][e], cu = u[j][e] * wu[0][e] + u[j + 1][e] * wu[1][e] + u[j + 2][e] * wu[2][e];
                    a[e] = cg / (1.0f + __expf(-cg)) * cu; }
                store8(ACT + (size_t)(pm * 256 + blk * 64 + j) * DFF + c0, a); }
        }
        else if (it < NT_A + NT_S) { const int j = it - NT_A, b = j / NCH, q = j - b * NCH; ffn_task<TS, true>(p, layer, nullptr, MP + b * TS, b, 0, 8 * q); }
        else { const int j = it - NT_A - NT_S, r = j / NCH, q = j - r * NCH; *(u32x4*)(ACT + (size_t)(MR + r) * DFF + 8 * q) = (u32x4){0u, 0u, 0u, 0u}; }
    }
}

__device__ __forceinline__ void cache_copy(const Params& p, int G) {
    float* out = p.out;
    for (int it = blockIdx.x * NTHR + threadIdx.x; it < NBS * (WIN - TS) * 128 * 2; it += G * NTHR) {
        const int kv = it & 1, e = it >> 1, c4 = e & 127, row = (e >> 7) % (WIN - TS), b = (e >> 7) / (WIN - TS);
        const float* src = p.in[kv ? I_CV : I_CK] + ((size_t)b * WIN + row + TS) * 512 + 4 * c4;
        *(f32x4*)(out + (kv ? O_V_S : O_K_S) + ((size_t)b * WIN + row) * 512 + 4 * c4) = *(const f32x4*)src;
    }
}

__device__ __forceinline__ int crow(int r, int hi) { return (r & 3) + 8 * (r >> 2) + 4 * hi; }
struct AttnRegs { u32x4 k[3], v[3]; float sink; };
constexpr int ATT_KST = 72, ATT_VST = 168;
#define ATTN_DECODE(u, samp, b, kh, qb) const bool samp = (u) >= NBP * NKV * (TP / 32); const int b = samp ? (((u) - NBP * NKV * (TP / 32)) >> 3) : ((u) >> 9), kh = samp ? ((u) & 7) : (((u) >> 6) & 7), qb = samp ? 0 : ((u) & 63)
template <bool SAMP> __device__ __forceinline__ void attn_load(const Params& p, int b, int kh, int qb, AttnRegs& R) {
    const int tid = threadIdx.x, lane = tid & 63, wid = __builtin_amdgcn_readfirstlane(tid >> 6), q = lane & 31, hi = lane >> 5;
    const bf16_t* QKV = (const bf16_t*)(p.ws + WS_PROJ);
    const int h = kh * 8 + wid;
    const u32x4 z = {0u, 0u, 0u, 0u};
#pragma unroll
    for (int it = 0; it < 3; ++it) {
        const int c = tid + it * NTHR, rr = c >> 3, ch = c & 7; R.k[it] = z; R.v[it] = z;
        if (c < 160 * 8) {
            if (!SAMP) { const int tk = qb * 32 - 128 + rr;
                if (tk >= 0) { const bf16_t* src = QKV + (size_t)(b * TP + tk) * NQKV + NH * HD + kh * HD + ch * 8; R.k[it] = *(const u32x4*)src; R.v[it] = *(const u32x4*)(src + NKV * HD); } }
            else if (rr < WIN) { float f[8]; const size_t o = (((size_t)b * WIN + rr) * NKV + kh) * HD + ch * 8;
                loadf8(p.in[I_CK] + o, f); R.k[it] = (u32x4){cvtpk(f[0], f[1]), cvtpk(f[2], f[3]), cvtpk(f[4], f[5]), cvtpk(f[6], f[7])};
                loadf8(p.in[I_CV] + o, f); R.v[it] = (u32x4){cvtpk(f[0], f[1]), cvtpk(f[2], f[3]), cvtpk(f[4], f[5]), cvtpk(f[6], f[7])}; }
            else if (rr < WIN + TS) { const bf16_t* src = QKV + (size_t)(MP + b * TS + (rr - WIN)) * NQKV + NH * HD + kh * HD + ch * 8; R.k[it] = *(const u32x4*)src; R.v[it] = *(const u32x4*)(src + NKV * HD); }
        }
    }
    R.sink = p.in[I_SINKS][h];
}
template <bool SAMP> __device__ __forceinline__ void attn_load_q(const Params& p, int b, int kh, int qb, bf16x8 (&qf)[4]) {
    const int tid = threadIdx.x, lane = tid & 63, wid = __builtin_amdgcn_readfirstlane(tid >> 6), q = lane & 31, hi = lane >> 5;
    const bf16_t* QKV = (const bf16_t*)(p.ws + WS_PROJ);
    const int h = kh * 8 + wid;
    const int qrow = SAMP ? MP + b * TS + (q < TS ? q : 0) : b * TP + qb * 32 + q;
#pragma unroll
    for (int d0 = 0; d0 < 4; ++d0) qf[d0] = *(const bf16x8*)(QKV + (size_t)qrow * NQKV + h * HD + 16 * d0 + 8 * hi);
}
__device__ __forceinline__ void attn_stage(LAS bf16_t* Ks, LAS bf16_t* Vt, const AttnRegs& R) {
    const int tid = threadIdx.x;
#pragma unroll
    for (int it = 0; it < 3; ++it) {
        const int c = tid + it * NTHR, rr = c >> 3, ch = c & 7;
        if (c < 160 * 8) {
            *(LAS u32x4*)(Ks + rr * ATT_KST + ch * 8) = R.k[it];
            LAS bf16_t* vd = Vt + (ch * 8) * ATT_VST + rr; const u32x4 v4 = R.v[it];
            vd[0 * ATT_VST] = (bf16_t)(v4.x & 0xffffu); vd[1 * ATT_VST] = (bf16_t)(v4.x >> 16); vd[2 * ATT_VST] = (bf16_t)(v4.y & 0xffffu); vd[3 * ATT_VST] = (bf16_t)(v4.y >> 16);
            vd[4 * ATT_VST] = (bf16_t)(v4.z & 0xffffu); vd[5 * ATT_VST] = (bf16_t)(v4.z >> 16); vd[6 * ATT_VST] = (bf16_t)(v4.w & 0xffffu); vd[7 * ATT_VST] = (bf16_t)(v4.w >> 16);
        }
    }
}
__device__ __forceinline__ void attn_math(const Params& p, LAS bf16_t* Ks, LAS bf16_t* Vt, const bf16x8 (&qf)[4], float sink, bool samp, int b, int kh, int qb) {
    const int tid = threadIdx.x, lane = tid & 63, wid = __builtin_amdgcn_readfirstlane(tid >> 6), q = lane & 31, hi = lane >> 5;
    bf16_t* OB = (bf16_t*)(p.ws + WS_CAT);
    constexpr float C2 = 0.125f * 1.4426950408889634f, L2E = 1.4426950408889634f;
    const int h = kh * 8 + wid;
    const int qrow = samp ? MP + b * TS + (q < TS ? q : 0) : b * TP + qb * 32 + q;
    f32x16 sc[5];
#pragma unroll
    for (int kb = 0; kb < 5; ++kb) {
#pragma unroll
        for (int i = 0; i < 16; ++i) sc[kb][i] = 0.f;
#pragma unroll
        for (int d0 = 0; d0 < 4; ++d0) { const bf16x8 kf = *(const LAS bf16x8*)(Ks + (kb * 32 + q) * ATT_KST + 16 * d0 + 8 * hi);
            sc[kb] = __builtin_amdgcn_mfma_f32_32x32x16_bf16(kf, qf[d0], sc[kb], 0, 0, 0); }
    }
    const int qp = samp ? PAST + q : qb * 32 + q, kbase = samp ? PAST - WIN : qb * 32 - WIN;
    const float sink2 = sink * L2E;
    float mx = sink2;
#pragma unroll
    for (int kb = 0; kb < 5; ++kb)
#pragma unroll
        for (int r = 0; r < 16; ++r) { const int kp = kbase + kb * 32 + crow(r, hi); const bool ok = (kp <= qp) && (kp > qp - WIN) && (kp >= 0);
            const float s = ok ? sc[kb][r] * C2 : -INFINITY; sc[kb][r] = s; mx = fmaxf(mx, s); }
    mx = fmaxf(mx, __shfl_xor(mx, 32));
    float sum = 0.f;
#pragma unroll
    for (int kb = 0; kb < 5; ++kb)
#pragma unroll
        for (int r = 0; r < 16; ++r) { const float e = __builtin_amdgcn_exp2f(sc[kb][r] - mx); sc[kb][r] = e; sum += e; }
    sum += __shfl_xor(sum, 32);
    sum += __builtin_amdgcn_exp2f(sink2 - mx);
    const float inv = 1.0f / sum;
    f32x16 o[2];
#pragma unroll
    for (int i = 0; i < 16; ++i) { o[0][i] = 0.f; o[1][i] = 0.f; }
#pragma unroll
    for (int s16 = 0; s16 < 10; ++s16) {
        const int kb = s16 >> 1, rb = 8 * (s16 & 1);
        u32x4 pw; pw.x = cvtpk(sc[kb][rb + 0], sc[kb][rb + 1]); pw.y = cvtpk(sc[kb][rb + 2], sc[kb][rb + 3]); pw.z = cvtpk(sc[kb][rb + 4], sc[kb][rb + 5]); pw.w = cvtpk(sc[kb][rb + 6], sc[kb][rb + 7]);
        const bf16x8 pf = __builtin_bit_cast(bf16x8, pw);
#pragma unroll
        for (int db = 0; db < 2; ++db) { const LAS bf16_t* vp = Vt + (q + 32 * db) * ATT_VST + 16 * s16 + 4 * hi;
            const u32x2 lo = *(const LAS u32x2*)vp, hh = *(const LAS u32x2*)(vp + 8);
            const bf16x8 vf = __builtin_bit_cast(bf16x8, (u32x4){lo.x, lo.y, hh.x, hh.y});
            o[db] = __builtin_amdgcn_mfma_f32_32x32x16_bf16(vf, pf, o[db], 0, 0, 0); }
    }
    if (!samp || q < TS) {
        bf16_t* orow = OB + (size_t)qrow * DM + h * HD + 4 * hi;
#pragma unroll
        for (int db = 0; db < 2; ++db)
#pragma unroll
            for (int g = 0; g < 4; ++g) *(u32x2*)(orow + 32 * db + 8 * g) = (u32x2){cvtpk(o[db][4 * g] * inv, o[db][4 * g + 1] * inv), cvtpk(o[db][4 * g + 2] * inv, o[db][4 * g + 3] * inv)};
    }
}
__device__ __forceinline__ void attn_phase(const Params& p, LAS unsigned char* lds, int G) {
    LAS bf16_t* Ks = (LAS bf16_t*)lds; LAS bf16_t* Vt = (LAS bf16_t*)(lds + 160 * ATT_KST * 2);
    constexpr int NU_P = NBP * NKV * (TP / 32), NU = NU_P + NBS * NKV;
    AttnRegs R;
    int u = blockIdx.x;
    if (u < NU_P) { ATTN_DECODE(u, s0, b0, kh0, qb0); (void)s0; attn_load<false>(p, b0, kh0, qb0, R); }
    for (; u < NU_P; u += G) {
        ATTN_DECODE(u, samp, b, kh, qb); (void)samp;
        bf16x8 qf[4]; attn_load_q<false>(p, b, kh, qb, qf);
        __syncthreads();
        attn_stage(Ks, Vt, R);
        const float sink = R.sink;
        __syncthreads();
        if (u + G < NU_P) { ATTN_DECODE(u + G, s2, b2, kh2, qb2); (void)s2; attn_load<false>(p, b2, kh2, qb2, R); }
        attn_math(p, Ks, Vt, qf, sink, false, b, kh, qb);
    }
    for (; u < NU; u += G) {
        ATTN_DECODE(u, samp, b, kh, qb); (void)samp;
        attn_load<true>(p, b, kh, qb, R);
        bf16x8 qf[4]; attn_load_q<true>(p, b, kh, qb, qf);
        __syncthreads();
        attn_stage(Ks, Vt, R);
        __syncthreads();
        attn_math(p, Ks, Vt, qf, R.sink, true, b, kh, qb);
    }
}

__device__ __forceinline__ void fold_sample(const Params& p, unsigned* cnt, const float* gain, float* rowss, LAS unsigned char* lds, int G) {
    const int tid = threadIdx.x, lane = tid & 63, wave = tid >> 6;
    if (tid == 0) { unsigned sp = 0; while (__hip_atomic_load(cnt, __ATOMIC_RELAXED, __HIP_MEMORY_SCOPE_AGENT) < 256u) { __builtin_amdgcn_s_sleep(2); if (++sp > (1u << 22)) break; }
        __builtin_amdgcn_fence(__ATOMIC_ACQUIRE, "agent"); asm volatile("s_waitcnt vmcnt(0)" ::: "memory"); }
    __syncthreads();
    float* X = (float*)(p.ws + WS_X); bf16_t* H = (bf16_t*)(p.ws + WS_H); const float* slab = (const float*)(p.ws + WS_SLAB);
    LAS float* red = (LAS float*)lds;
    for (int hr = blockIdx.x; hr < 2 * MS; hr += G) {
        const int srow = hr >> 1, col = (hr & 1) * 2048 + tid * 4;
        float* xq = X + (size_t)(MP + srow) * DM + col;
        f32x4 v = *(const f32x4*)xq;
        const bf16_t* sp = (const bf16_t*)slab + (size_t)srow * DM + col;
#pragma unroll
        for (int q = 0; q < S_RES; ++q) { const u32x2 w = *(const u32x2*)(sp + (size_t)q * 128 * DM); v += (f32x4){bflo(w.x), bfhi(w.x), bflo(w.y), bfhi(w.y)}; }
        *(f32x4*)xq = v;
        if (gain) {
        const f32x4 h = v * *(const f32x4*)(gain + col);
        *(u32x2*)(H + (size_t)(MP + srow) * DM + col) = (u32x2){cvtpk(h.x, h.y), cvtpk(h.z, h.w)};
        const float ss = wave_sum((v.x * v.x + v.y * v.y) + (v.z * v.z + v.w * v.w));
        if (lane == 0) red[wave] = ss;
        __syncthreads();
        if (tid == 0) unsafeAtomicAdd(rowss + MP + srow, ((red[0] + red[1]) + (red[2] + red[3])) + ((red[4] + red[5]) + (red[6] + red[7])));
        __syncthreads(); }
    }
}

__device__ __forceinline__ void fold_bf16(const Params& p, unsigned* cnt, unsigned need, int parts, int ncols, bf16_t* dst, int ldd, int col0, const float* rowss, int G, int gu_pn0 = -1) {
    const int tid = threadIdx.x;
    if (tid == 0) { unsigned sp = 0; while (__hip_atomic_load(cnt, __ATOMIC_RELAXED, __HIP_MEMORY_SCOPE_AGENT) < need) { __builtin_amdgcn_s_sleep(2); if (++sp > (1u << 22)) break; }
        __builtin_amdgcn_fence(__ATOMIC_ACQUIRE, "agent"); asm volatile("s_waitcnt vmcnt(0)" ::: "memory"); }
    __syncthreads();
    const float* slab = (const float*)(p.ws + WS_SLAB);
    const int cpr = ncols / 8;
    for (int ch = blockIdx.x * NTHR + tid; ch < MS * cpr; ch += G * NTHR) {
        const int srow = ch / cpr, c = (ch - srow * cpr) * 8;
        const bf16_t* sp = (const bf16_t*)slab + (size_t)srow * ncols + c;
        f32x4 a = {0.f, 0.f, 0.f, 0.f}, b = {0.f, 0.f, 0.f, 0.f};
        for (int q = 0; q < parts; ++q) { const u32x4 w = *(const u32x4*)sp; a += (f32x4){bflo(w.x), bfhi(w.x), bflo(w.y), bfhi(w.y)}; b += (f32x4){bflo(w.z), bfhi(w.z), bflo(w.w), bfhi(w.w)}; sp += (size_t)128 * ncols; }
        const float rs = rowss ? 1.0f / sqrtf(rowss[MP + srow] * (1.0f / DM) + EPS) : 1.0f;
        a *= rs; b *= rs;
        const int dcol = gu_pn0 < 0 ? col0 + c : ((c >> 7) & 1) * DFF + (gu_pn0 + (c >> 8)) * 128 + (c & 127);
        *(u32x4*)(dst + (size_t)(MP + srow) * ldd + dcol) = (u32x4){cvtpk(a.x, a.y), cvtpk(a.z, a.w), cvtpk(b.x, b.y), cvtpk(b.z, b.w)};
    }
}

constexpr int NPHASE = 19;
__global__ void __launch_bounds__(NTHR, 2) trunk_fwd(Params p) {
    extern __shared__ __attribute__((aligned(16))) unsigned char lds_raw[];
    LAS unsigned char* lds = (LAS unsigned char*)lds_raw;
    volatile LAS unsigned* MISC = (volatile LAS unsigned*)(lds + MISC_OFF);
    const int tid = threadIdx.x, G = gridDim.x;
    unsigned char* ws = p.ws;
    for (int u = tid; u < (LDS_BYTES - LDSCTL_OFF) / 4; u += NTHR) ((LAS unsigned*)(lds + LDSCTL_OFF))[u] = 0u;
    __syncthreads();
#if MK_SPLIT
#define GRID_BAR() do { } while (0)
#else
    XcdBarrier bar = xcd_barrier_post((unsigned*)(ws + WS_CTL) + CW_BAR, MISC + 8);
#define GRID_BAR() do { if (BG_CONV) xcd_barrier_bg(bar, p, lds); else xcd_barrier(bar); } while (0)
#endif
    const int lo = p.ph_lo, hi = p.ph_hi;
#define IN(k) (lo <= (k) && (k) < hi)
#define BG_DL(k) ((k) == 4 ? BQ_UP0 : (k) == 7 ? BQ_DN0 : (k) == 8 ? BQ_QKV : (k) == 12 ? BQ_O : (k) == 13 ? BQ_UP1 : (k) == 16 ? BQ_DN1 : 0)
#define SEAM(k) do { if ((k) + 1 < hi) { if (BG_CONV != 0 && BG_DL(k) != 0) bg_drain(p, lds, MISC + 8, BG_DL(k)); GRID_BAR(); } } while (0)
    const bf16_t* Hb = (const bf16_t*)(ws + WS_H);
    float* X = (float*)(ws + WS_X);
    float* slab = (float*)(ws + WS_SLAB);

    const float* IG = (const float*)(ws + WS_IGAIN);
    float* RS = (float*)(ws + WS_ROWSS);
    unsigned* FC = (unsigned*)(ws + WS_CTL) + CW_FOLD;
    bf16_t* Hw = (bf16_t*)(ws + WS_H);

    if (IN(0)) { REP(0) { prologue_phase(p, lds, G); cache_copy(p, G); norm_phase<0>(p, p.in[I_NMIX], G); } SEAM(0); }
    if (IN(1)) {
        pg8::Gemm g{Hb, (const bf16_t*)(ws + WS_WIN), DM, DM}; pg8::StaticOrder S; S.init(NIN, DM, DM, DM, 0, S_IN, G, (int)blockIdx.x, 1);
        pg8::EpiBf16 E{(bf16_t*)(ws + WS_PROJ), NIN, 0, nullptr, nullptr, nullptr};
        pg8::gemm_phase(lds, g, S, E, slab, NIN, 0, FC + 192); fold_bf16(p, FC + 192, 256u, S_IN, NIN, (bf16_t*)(ws + WS_PROJ), NIN, 0, nullptr, G); SEAM(1); }
    if (IN(2)) { REP(2) mixer_phase(p, G); SEAM(2); }
    if (IN(3)) {
        pg8::Gemm g{(const bf16_t*)(ws + WS_POOLED), (const bf16_t*)(ws + WS_WPOOL), DB, PGRP}; pg8::PoolOrder S; S.init(G, (int)blockIdx.x);
        pg8::EpiBf16 E{(bf16_t*)(ws + WS_CAT) + DA, DM, PGRP, nullptr, p.in[I_PSCALE], nullptr};
        pg8::gemm_phase(lds, g, S, E, slab, 0, 0); SEAM(3); }
    if (IN(4)) {
        pg8::Gemm g{(const bf16_t*)(ws + WS_CAT), (const bf16_t*)(ws + WS_WOUT), DM, DM}; pg8::StaticOrder S; S.init(DM, DM, DM, DM, 0, S_RES, G, (int)blockIdx.x, 1);
        pg8::EpiResid E{Hw, IG + 3 * DM, RS + 4 * MPAD, Hw, p.in[I_NFFN], RS};
        pg8::gemm_phase(lds, g, S, E, slab, DM, 0, FC); fold_sample(p, FC, p.in[I_NFFN], RS, lds, G); SEAM(4); }
    if (IN(6)) {
        pg8::Gemm g{Hb, (const bf16_t*)(ws + WS_WUP), DM, DM}; pg8::StaticOrder S; S.init(NUP, DM, DM, DM, UP_PNSPLIT, S_UP, G, (int)blockIdx.x, 1, pg8::HALF);
        pg8::EpiUpConv E{(bf16_t*)(ws + WS_U), (bf16_t*)(ws + WS_ACT), (bf16_t*)(ws + WS_HALO), RS, p.in[I_CONVF] + (size_t)0 * 3 * NUP, p.out + O_F_P + (size_t)0 * NBP * 2 * NUP};
        pg8::gemm_phase(lds, g, S, E, slab, NUP - UP_PNSPLIT * 256, UP_PNSPLIT, FC + 256);
        fold_bf16(p, FC + 256, (unsigned)((NUP / 256 - UP_PNSPLIT) * S_UP), S_UP, NUP - UP_PNSPLIT * 256, (bf16_t*)(ws + WS_U), NUP, 0, RS, G, UP_PNSPLIT); SEAM(6); }
    if (IN(7)) { ffnfix_phase(p, 0, G); SEAM(7); }
    if (IN(8)) {
        pg8::Gemm g{(const bf16_t*)(ws + WS_ACT), (const bf16_t*)(ws + WS_WDN), DFF, DFF}; pg8::StaticOrder S; S.init(DM, DFF, DFF, DFF, 0, S_RES, G, (int)blockIdx.x, 1);
        pg8::EpiResid E{Hw, IG, nullptr, Hw, p.in[I_NMIX] + DM, RS + MPAD};
        pg8::gemm_phase(lds, g, S, E, slab, DM, 0, FC + 64); fold_sample(p, FC + 64, p.in[I_NMIX] + DM, RS + MPAD, lds, G); SEAM(8); }
    if (IN(10)) {
        pg8::Gemm g{Hb, (const bf16_t*)(ws + WS_WQKV), DM, DM}; pg8::StaticOrder S; S.init(NQKV, DM, DM, DM, NQKV / 256, 1, G, (int)blockIdx.x);
        pg8::EpiQKV E{(bf16_t*)(ws + WS_PROJ), p.in[I_BQKV], RS + MPAD, (const f32x4*)(ws + WS_ROPE), p.out};
        pg8::gemm_phase(lds, g, S, E, slab, 0, 0); SEAM(10); }
    if (IN(12)) { REP(12) attn_phase(p, lds, G); SEAM(12); }
    if (IN(13)) {
        pg8::Gemm g{(const bf16_t*)(ws + WS_CAT), (const bf16_t*)(ws + WS_WO), DM, DM}; pg8::StaticOrder S; S.init(DM, DM, DM, DM, 0, S_RES, G, (int)blockIdx.x, 1);
        pg8::EpiResid E{Hw, IG + DM, nullptr, Hw, p.in[I_NFFN] + DM, RS + 2 * MPAD};
        pg8::gemm_phase(lds, g, S, E, slab, DM, 0, FC + 128); fold_sample(p, FC + 128, p.in[I_NFFN] + DM, RS + 2 * MPAD, lds, G); SEAM(13); }
    if (IN(15)) {
        pg8::Gemm g{Hb, (const bf16_t*)(ws + WS_WUP) + WUP_STRIDE, DM, DM}; pg8::StaticOrder S; S.init(NUP, DM, DM, DM, UP_PNSPLIT, S_UP, G, (int)blockIdx.x, 1, pg8::HALF);
        pg8::EpiUpConv E{(bf16_t*)(ws + WS_U), (bf16_t*)(ws + WS_ACT), (bf16_t*)(ws + WS_HALO), RS + 2 * MPAD, p.in[I_CONVF] + (size_t)1 * 3 * NUP, p.out + O_F_P + (size_t)1 * NBP * 2 * NUP};
        pg8::gemm_phase(lds, g, S, E, slab, NUP - UP_PNSPLIT * 256, UP_PNSPLIT, FC + 320);
        fold_bf16(p, FC + 320, (unsigned)((NUP / 256 - UP_PNSPLIT) * S_UP), S_UP, NUP - UP_PNSPLIT * 256, (bf16_t*)(ws + WS_U), NUP, 0, RS + 2 * MPAD, G, UP_PNSPLIT); SEAM(15); }
    if (IN(16)) { ffnfix_phase(p, 1, G); SEAM(16); }
    if (IN(17)) {
        pg8::Gemm g{(const bf16_t*)(ws + WS_ACT), (const bf16_t*)(ws + WS_WDN) + WDN_STRIDE, DFF, DFF}; pg8::StaticOrder S; S.init(DM, DFF, DFF, DFF, 0, S_RES, G, (int)blockIdx.x, 1);
        pg8::EpiResid E{Hw, IG + 2 * DM, nullptr, Hw, p.in[I_NFIN], RS + 3 * MPAD};
        pg8::gemm_phase(lds, g, S, E, slab, DM, 0, FC + 384); fold_sample(p, FC + 384, nullptr, nullptr, lds, G); SEAM(17); }
    if (IN(18)) { norm_phase<2>(p, p.in[I_NFIN], G); }
#undef IN
#undef SEAM
#undef GRID_BAR
}

extern "C" void kernel_launch(void* const* d_in, const int* in_sizes, int n_in, void* d_out, int out_size, void* d_ws, size_t ws_size, hipStream_t stream) {
    static int grid = 0;
    if (grid == 0) {
        if (n_in != 22 || (size_t)out_size != O_END || ws_size < WS_END) { fprintf(stderr, "kernel_launch: unexpected shapes: n_in %d out %d (want %zu) ws %zu (need %zu); nothing launched\n", n_in, out_size, (size_t)O_END, ws_size, (size_t)WS_END); grid = -1; return; }
        int dev = 0, cus = 0, per_cu = 0;
        if (hipGetDevice(&dev) != hipSuccess || hipDeviceGetAttribute(&cus, hipDeviceAttributeMultiprocessorCount, dev) != hipSuccess) { grid = -1; return; }
        if (hipFuncSetAttribute((const void*)trunk_fwd, hipFuncAttributeMaxDynamicSharedMemorySize, LDS_BYTES) != hipSuccess) { fprintf(stderr, "kernel_launch: hipFuncSetAttribute failed\n"); grid = -1; return; }
        if (hipOccupancyMaxActiveBlocksPerMultiprocessor(&per_cu, (const void*)trunk_fwd, NTHR, LDS_BYTES) != hipSuccess || per_cu < 1) fprintf(stderr, "kernel_launch: occupancy query reports %d\n", per_cu);
        (void)hipGetLastError();
        grid = cus;
    }
    if (grid < 0) return;
    (void)hipMemsetAsync((char*)d_ws + WS_CTL, 0, CTL_ZERO_BYTES, stream);
    Params a{};
    for (int i = 0; i < 22; ++i) a.in[i] = (const float*)d_in[i];
    a.out = (float*)d_out; a.ws = (unsigned char*)d_ws;
#if MK_SPLIT
    for (int ph = 0; ph < NPHASE; ++ph) { a.ph_lo = ph; a.ph_hi = ph + 1; hipLaunchKernelGGL(trunk_fwd, dim3(grid), dim3(NTHR), LDS_BYTES, stream, a); }
#else
    a.ph_lo = 0; a.ph_hi = NPHASE;
    hipLaunchKernelGGL(trunk_fwd, dim3(grid), dim3(NTHR), LDS_BYTES, stream, a);
#endif
}
```
